# Optimizing an MI355X kernel written in HIP

```python
import jax, jax.numpy as jnp
from jax import lax
import numpy as np

D_MODEL = 2048
BATCH = 2
SEQ = 8192
DEPTH = 4

CHUNK = 64
N_MIXERS = 2
N_HEADS = 16
HEAD_DIM = D_MODEL // N_HEADS
Q_BLOCK = 128
SGU_CHUNK = 128
SGU_WIDTH = D_MODEL
SGU_GROUPS = 16
SGU_GROUP_DIM = SGU_WIDTH // SGU_GROUPS
D_FF = 4 * D_MODEL
N_FOX = (DEPTH + 1) // 2
N_SGU = DEPTH // 2
EPS = 1e-6
NEG_INF = -1e30

kernel_name = "fox_gmlp_interleaved_hybrid"


def rmsnorm(x, g):
    xf = x.astype(jnp.float32)
    y = xf * lax.rsqrt(jnp.mean(xf * xf, axis=-1, keepdims=True) + EPS)
    return (y * g.astype(jnp.float32)).astype(x.dtype)


def forgetting_attention(h, w_in, b_f, g_q, g_k, w_out):
    B, S, _ = h.shape
    proj = h @ w_in
    q, k, v, f_logit = jnp.split(proj, [D_MODEL, 2 * D_MODEL, 3 * D_MODEL], axis=-1)
    q = q.reshape(B, S, N_HEADS, HEAD_DIM)
    k = k.reshape(B, S, N_HEADS, HEAD_DIM)
    v = v.reshape(B, S, N_HEADS, HEAD_DIM)
    q = rmsnorm(q, g_q).astype(jnp.float32) * (HEAD_DIM ** -0.5)
    k = rmsnorm(k, g_k).astype(jnp.float32)
    log_f = jax.nn.log_sigmoid((f_logit + b_f).astype(jnp.float32))
    c = jnp.cumsum(log_f, axis=1).transpose(0, 2, 1)
    outs = []
    for i in range(S // Q_BLOCK):
        q0 = i * Q_BLOCK
        kend = q0 + Q_BLOCK
        qb = q[:, q0:kend]
        kb = k[:, :kend]
        vb = v[:, :kend]
        s = jnp.einsum('bqhd,bkhd->bhqk', qb, kb)
        s = s + (c[:, :, q0:kend, None] - c[:, :, None, :kend])
        q_pos = q0 + jnp.arange(Q_BLOCK)
        k_pos = jnp.arange(kend)
        mask = k_pos[None, :] <= q_pos[:, None]
        s = jnp.where(mask[None, None], s, NEG_INF)
        p = jax.nn.softmax(s, axis=-1)
        outs.append(jnp.einsum('bhqk,bkhd->bqhd', p.astype(vb.dtype), vb))
    o = jnp.concatenate(outs, axis=1).reshape(B, S, D_MODEL)
    return o @ w_out


def spatial_gating(h, w_in, b_in, g_v, w_s, b_s, w_out):
    B, S, _ = h.shape
    uv = jax.nn.gelu(h @ w_in + b_in)
    u, v = jnp.split(uv, 2, axis=-1)
    n_chunks = S // SGU_CHUNK
    v = v.reshape(B, n_chunks, SGU_CHUNK, SGU_GROUPS, SGU_GROUP_DIM)
    v = rmsnorm(v, g_v)
    tril = jnp.tril(jnp.ones((SGU_CHUNK, SGU_CHUNK), dtype=bool))
    w_causal = jnp.where(tril[None], w_s, jnp.zeros_like(w_s))
    mixed = jnp.einsum('gts,bnsgd->bntgd', w_causal, v)
    mixed = mixed + b_s.T[None, None, :, :, None]
    gated = u * mixed.reshape(B, S, SGU_WIDTH)
    return gated @ w_out


def squared_relu_mlp(h, w1, w2):
    a = jax.nn.relu(h @ w1)
    return (a * a) @ w2


def setup_inputs(seed: int = 0) -> dict:
    key = jax.random.key(seed)
    ks = jax.random.split(key, 20)
    f32 = jnp.float32
    d_in = D_MODEL ** -0.5
    x = jax.random.normal(ks[0], (BATCH, SEQ, D_MODEL), f32)
    g_mix = 1.0 + 0.05 * jax.random.normal(ks[1], (DEPTH, D_MODEL), f32)
    g_mlp = 1.0 + 0.05 * jax.random.normal(ks[2], (DEPTH, D_MODEL), f32)
    fox_w_in = d_in * jax.random.normal(ks[3], (N_FOX, D_MODEL, 3 * D_MODEL + N_HEADS), f32)
    fox_b_f = jnp.linspace(2.0, 6.0, N_HEADS, dtype=f32)[None, :] + 0.1 * jax.random.normal(ks[4], (N_FOX, N_HEADS), f32)
    fox_g_q = 1.0 + 0.05 * jax.random.normal(ks[5], (N_FOX, HEAD_DIM), f32)
    fox_g_k = 1.0 + 0.05 * jax.random.normal(ks[6], (N_FOX, HEAD_DIM), f32)
    fox_w_out = d_in * jax.random.normal(ks[7], (N_FOX, D_MODEL, D_MODEL), f32)
    sgu_w_in = d_in * jax.random.normal(ks[8], (N_SGU, D_MODEL, 2 * SGU_WIDTH), f32)
    sgu_b_in = 0.02 * jax.random.normal(ks[9], (N_SGU, 2 * SGU_WIDTH), f32)
    sgu_g_v = 1.0 + 0.05 * jax.random.normal(ks[10], (N_SGU, SGU_GROUPS, SGU_GROUP_DIM), f32)
    sgu_w_s = 0.5 * SGU_CHUNK ** -0.5 * jax.random.normal(ks[11], (N_SGU, SGU_GROUPS, SGU_CHUNK, SGU_CHUNK), f32)
    sgu_b_s = 1.0 + 0.1 * jax.random.normal(ks[12], (N_SGU, SGU_GROUPS, SGU_CHUNK), f32)
    sgu_w_out = SGU_WIDTH ** -0.5 * jax.random.normal(ks[13], (N_SGU, SGU_WIDTH, D_MODEL), f32)
    mlp_w1 = d_in * jax.random.normal(ks[14], (DEPTH, D_MODEL, D_FF), f32)
    mlp_w2 = 0.5 * D_FF ** -0.5 * jax.random.normal(ks[15], (DEPTH, D_FF, D_MODEL), f32)
    return {"x": x, "g_mix": g_mix, "g_mlp": g_mlp,
            "fox_w_in": fox_w_in, "fox_b_f": fox_b_f, "fox_g_q": fox_g_q, "fox_g_k": fox_g_k, "fox_w_out": fox_w_out,
            "sgu_w_in": sgu_w_in, "sgu_b_in": sgu_b_in, "sgu_g_v": sgu_g_v, "sgu_w_s": sgu_w_s, "sgu_b_s": sgu_b_s, "sgu_w_out": sgu_w_out,
            "mlp_w1": mlp_w1, "mlp_w2": mlp_w2}


def reference(x, g_mix, g_mlp, fox_w_in, fox_b_f, fox_g_q, fox_g_k, fox_w_out,
              sgu_w_in, sgu_b_in, sgu_g_v, sgu_w_s, sgu_b_s, sgu_w_out, mlp_w1, mlp_w2):
    for i in range(DEPTH):
        h = rmsnorm(x, g_mix[i])
        j = i // N_MIXERS
        if i % N_MIXERS == 0:
            x = x + forgetting_attention(h, fox_w_in[j], fox_b_f[j], fox_g_q[j], fox_g_k[j], fox_w_out[j])
        else:
            x = x + spatial_gating(h, sgu_w_in[j], sgu_b_in[j], sgu_g_v[j], sgu_w_s[j], sgu_b_s[j], sgu_w_out[j])
        h = rmsnorm(x, g_mlp[i])
        x = x + squared_relu_mlp(h, mlp_w1[i], mlp_w2[i])
    return x
```

```cpp
#include <hip/hip_runtime.h>
#include <hip/hip_cooperative_groups.h>
#include <cstdio>
#include <cstdint>
namespace cg = cooperative_groups;
namespace pg8 {
#define PG8_LAS __attribute__((address_space(3)))
typedef unsigned short bf16_t;
typedef short bf16x8 __attribute__((ext_vector_type(8)));
typedef float f32x4 __attribute__((ext_vector_type(4)));
typedef unsigned u32x4 __attribute__((ext_vector_type(4)));
constexpr int BM = 256, BK = 64, HALF = 128, HTB = HALF * BK * 2  , STAGE_BYTES = 8 * HTB, NXCD = 8, WGM = 8;

__host__ __device__ __forceinline__ int lds_byte(int r, int c) { const int st = (r >> 4) * 2 + (c >> 5), rr = r & 15, cc = c & 31, ob = rr * 64 + cc * 2; return st * 1024 + (ob ^ (((ob >> 9) & 1) << 5)); }
__host__ __device__ __forceinline__ void stage_rc(int b, int& R, int& C) { const int st = b / 1024, sb = b % 1024, swz = sb ^ (((sb >> 9) & 1) << 5); R = (st >> 1) * 16 + swz / 64; C = (st & 1) * 32 + (swz % 64) / 2; }
__host__ __device__ __forceinline__ int perm32(int rho) { const int n = rho >> 4, i = rho & 15; return 8 * (i >> 2) + 4 * n + (i & 3); }

struct Unit { int pm, pn; };
struct Gemm { const bf16_t* A; const bf16_t* Bt; int M, N, K; };

struct StaticOrder {
    int nM, nN, nwg, G, c, wgm;
    __host__ __device__ void init(int M, int N, int G_, int c_, int wgm_ = WGM) { nM = M / BM; nN = N / BM; nwg = nM * nN; G = G_; c = c_; wgm = wgm_; }
    __host__ __device__ bool next(int i, Unit& u) const {
        const long L = (long)i * G + c; if (L >= nwg) return false;
        int wgid = (int)L; { const int q = nwg / NXCD, r = nwg % NXCD, xcd = wgid % NXCD, off = wgid / NXCD; wgid = (xcd < r ? xcd * (q + 1) : r * (q + 1) + (xcd - r) * q) + off; }
        const int nig = wgm * nN, gid = wgid / nig, fm = gid * wgm, gsz = (nM - fm) < wgm ? (nM - fm) : wgm;
        u.pm = fm + ((wgid % nig) % gsz); u.pn = (wgid % nig) / gsz; return true;
    }
    __device__ __forceinline__ void a_ready(const Unit&) const {}
    __device__ __forceinline__ void done(const Unit&) const {}
};

__device__ __forceinline__ unsigned cvt_pk_bf16(float lo, float hi) { unsigned r; asm volatile("v_cvt_pk_bf16_f32 %0, %1, %2" : "=v"(r) : "v"(lo), "v"(hi)); return r; }
typedef float f32x2 __attribute__((ext_vector_type(2)));
typedef unsigned u32x2 __attribute__((ext_vector_type(2)));
__device__ __forceinline__ float rstd_row(const float* part, int row) { const f32x4 a = *(const f32x4*)(part + (size_t)row * 8), b = *(const f32x4*)(part + (size_t)row * 8 + 4);
    return __builtin_amdgcn_rsqf((((a[0] + a[1]) + (a[2] + a[3])) + ((b[0] + b[1]) + (b[2] + b[3]))) * (1.0f / 2048.0f) + 1e-6f); }
__device__ __forceinline__ float act_relu2(float v) { const float r = fmaxf(v, 0.f); return r * r; }
__device__ __forceinline__ float act_gelu_tanh(float x) {
    const float u = 0.7978845608028654f * (x + 0.044715f * x * x * x);
    const float t = __builtin_amdgcn_exp2f(u * 2.8853900817779268f);
    return x - x * __builtin_amdgcn_rcpf(t + 1.0f);
}
#ifdef WT_STORES
__device__ __forceinline__ void st16(void* p, u32x4 w) { asm volatile("global_store_dwordx4 %0, %1, off sc0 sc1\n\ts_nop 1" :: "v"(p), "v"(w) : "memory"); }
#else
__device__ __forceinline__ void st16(void* p, u32x4 w) { *(u32x4*)p = w; }
#endif
template <int ACT> struct EpiAct {
    static constexpr bool PERM = true, AFTER_DRAIN = false;
    bf16_t* O; int ldc; const float* bias; const float* ssq; int nostore;
    __device__ __forceinline__ void operator()(const f32x4 (&acc)[2][2][4][2], const Unit& u, int wr, int wc, int fr, int fq) const {
        const int row0 = u.pm * BM + wr * 64 + fr; const int col0 = u.pn * BM + wc * 32 + 8 * fq;
        f32x4 bv[2][2];
#pragma unroll
        for (int bj = 0; bj < 2; ++bj)
#pragma unroll
            for (int n = 0; n < 2; ++n) bv[bj][n] = bias ? *(const f32x4*)(bias + col0 + bj * HALF + 4 * n) : (f32x4){0.f, 0.f, 0.f, 0.f};
#pragma unroll
        for (int ai = 0; ai < 2; ++ai)
#pragma unroll
            for (int m = 0; m < 4; ++m) { const int row = row0 + ai * HALF + m * 16; const float rs = (ACT == 1) ? 1.f : rstd_row(ssq, row); bf16_t* rowp = O + (size_t)row * ldc + col0;
#pragma unroll
                for (int bj = 0; bj < 2; ++bj) { f32x4 v0, v1;
                    if (ACT == 1) { const f32x4 a0 = acc[ai][bj][m][0], a1 = acc[ai][bj][m][1]; const float rs2 = rs * rs;
                        v0 = (f32x4){act_relu2(a0[0]), act_relu2(a0[1]), act_relu2(a0[2]), act_relu2(a0[3])} * rs2; v1 = (f32x4){act_relu2(a1[0]), act_relu2(a1[1]), act_relu2(a1[2]), act_relu2(a1[3])} * rs2; }
                    else { v0 = acc[ai][bj][m][0] * rs + bv[bj][0]; v1 = acc[ai][bj][m][1] * rs + bv[bj][1]; }
                    if (0) { v0 = (f32x4){act_relu2(v0[0]), act_relu2(v0[1]), act_relu2(v0[2]), act_relu2(v0[3])}; v1 = (f32x4){act_relu2(v1[0]), act_relu2(v1[1]), act_relu2(v1[2]), act_relu2(v1[3])}; }
                    if (ACT == 2) { v0 = (f32x4){act_gelu_tanh(v0[0]), act_gelu_tanh(v0[1]), act_gelu_tanh(v0[2]), act_gelu_tanh(v0[3])}; v1 = (f32x4){act_gelu_tanh(v1[0]), act_gelu_tanh(v1[1]), act_gelu_tanh(v1[2]), act_gelu_tanh(v1[3])}; }
                    u32x4 w; w.x = cvt_pk_bf16(v0[0], v0[1]); w.y = cvt_pk_bf16(v0[2], v0[3]); w.z = cvt_pk_bf16(v1[0], v1[1]); w.w = cvt_pk_bf16(v1[2], v1[3]);
                    if (!nostore) st16(rowp + bj * HALF, w); } }
    }
};
struct EpiQKV {
    static constexpr bool PERM = true, AFTER_DRAIN = false;
    bf16_t* QH; const float* ssq; const float* gq; const float* gk; PG8_LAS float* X; int mode;
    __device__ __forceinline__ void operator()(const f32x4 (&acc)[2][2][4][2], const Unit& u, int wr, int wc, int fr, int fq) const {
        const int sec = (mode & 1) ? 2 : (u.pn >> 3); const int row0 = u.pm * BM + wr * 64 + fr;
        if (sec < 2) {
#pragma unroll
            for (int ai = 0; ai < 2; ++ai)
#pragma unroll
                for (int m = 0; m < 4; ++m)
#pragma unroll
                    for (int bj = 0; bj < 2; ++bj) { const f32x4 a0 = acc[ai][bj][m][0], a1 = acc[ai][bj][m][1];
                        float s = ((a0[0] * a0[0] + a0[1] * a0[1]) + (a0[2] * a0[2] + a0[3] * a0[3])) + ((a1[0] * a1[0] + a1[1] * a1[1]) + (a1[2] * a1[2] + a1[3] * a1[3]));
                        s += __shfl_xor(s, 16); s += __shfl_xor(s, 32);
                        if (fq == 0) X[((ai * HALF + wr * 64 + m * 16 + fr) * 2 + bj) * 4 + wc] = s; }
            asm volatile("s_waitcnt lgkmcnt(0)\n\ts_barrier" ::: "memory");
        }
        int dcol = wc * 32 + 8 * fq; asm volatile("" : "+v"(dcol));
        f32x4 g0 = {1.f, 1.f, 1.f, 1.f}, g1 = {1.f, 1.f, 1.f, 1.f};
        if (sec == 0) { const int d = dcol; const f32x4 q0 = *(const f32x4*)(gq + d), q1 = *(const f32x4*)(gq + d + 4), k0 = *(const f32x4*)(gk + d), k1 = *(const f32x4*)(gk + d + 4);
            g0 = q0 * k0 * (0.08838834764831845f * 1.4426950408889634f); g1 = q1 * k1 * (0.08838834764831845f * 1.4426950408889634f); }
        bf16_t* sbase = QH + (size_t)sec * ((size_t)32 * 8192 * 128) + dcol;
#pragma unroll
        for (int ai = 0; ai < 2; ++ai)
#pragma unroll
            for (int m = 0; m < 4; ++m) { const int row = row0 + ai * HALF + m * 16; const int b = row >> 13, s = row & 8191; const float rs = rstd_row(ssq, row);
#pragma unroll
                for (int bj = 0; bj < 2; ++bj) { const int head = (u.pn & 7) * 2 + bj; float fac = rs;
                    if (sec < 2) { const f32x4 p = *(const PG8_LAS f32x4*)(X + ((ai * HALF + wr * 64 + m * 16 + fr) * 2 + bj) * 4);
                        fac = rs * __builtin_amdgcn_rsqf(((p[0] + p[1]) + (p[2] + p[3])) * (rs * rs) * (1.0f / 128.0f) + 1e-6f); }
                    const f32x4 v0 = acc[ai][bj][m][0] * fac * g0, v1 = acc[ai][bj][m][1] * fac * g1;
                    u32x4 w; w.x = cvt_pk_bf16(v0[0], v0[1]); w.y = cvt_pk_bf16(v0[2], v0[3]); w.z = cvt_pk_bf16(v1[0], v1[1]); w.w = cvt_pk_bf16(v1[2], v1[3]);
                    if (!(mode & 2)) st16(sbase + ((size_t)(b * 16 + head) * 8192 + s) * 128, w); } }
    }
};
struct EpiResid {
    static constexpr bool PERM = true, AFTER_DRAIN = false;
    const float* xin32; float* out32; bf16_t* xb; float* part; PG8_LAS float* X; const float* scale_part;
    __device__ __forceinline__ void operator()(const f32x4 (&acc)[2][2][4][2], const Unit& u, int wr, int wc, int fr, int fq) const {
        const int row0 = u.pm * BM + wr * 64 + fr; const int col0 = u.pn * BM + wc * 32 + 8 * fq;
#pragma unroll
        for (int ai = 0; ai < 2; ++ai)
#pragma unroll
            for (int m = 0; m < 4; ++m) { const int row = row0 + ai * HALF + m * 16; const size_t off = (size_t)row * 2048 + col0; float s = 0.f; float sc2 = 1.f;
                if (scale_part) { const float r_ = rstd_row(scale_part, row); sc2 = r_ * r_; }
#pragma unroll
                for (int bj = 0; bj < 2; ++bj) { f32x4 x0, x1;
                    if (xin32) { x0 = *(const f32x4*)(xin32 + off + bj * HALF); x1 = *(const f32x4*)(xin32 + off + bj * HALF + 4); }
                    else { const u32x4 w = *(const u32x4*)(xb + off + bj * HALF);
                        x0 = (f32x4){__uint_as_float(w.x << 16), __uint_as_float(w.x & 0xffff0000u), __uint_as_float(w.y << 16), __uint_as_float(w.y & 0xffff0000u)};
                        x1 = (f32x4){__uint_as_float(w.z << 16), __uint_as_float(w.z & 0xffff0000u), __uint_as_float(w.w << 16), __uint_as_float(w.w & 0xffff0000u)}; }
                    const f32x4 v0 = x0 + acc[ai][bj][m][0] * sc2, v1 = x1 + acc[ai][bj][m][1] * sc2;
                    if (out32) { *(f32x4*)(out32 + off + bj * HALF) = v0; *(f32x4*)(out32 + off + bj * HALF + 4) = v1; }
                    s += ((v0[0] * v0[0] + v0[1] * v0[1]) + (v0[2] * v0[2] + v0[3] * v0[3])) + ((v1[0] * v1[0] + v1[1] * v1[1]) + (v1[2] * v1[2] + v1[3] * v1[3]));
                    u32x4 w; w.x = cvt_pk_bf16(v0[0], v0[1]); w.y = cvt_pk_bf16(v0[2], v0[3]); w.z = cvt_pk_bf16(v1[0], v1[1]); w.w = cvt_pk_bf16(v1[2], v1[3]);
                    if (!out32) st16(xb + off + bj * HALF, w); }
                if (!out32) { s += __shfl_xor(s, 16); s += __shfl_xor(s, 32);
                if (fq == 0) X[(ai * HALF + wr * 64 + m * 16 + fr) * 4 + wc] = s; }
                asm volatile("" ::: "memory"); }
        if (out32) return;
        asm volatile("s_waitcnt lgkmcnt(0)\n\ts_barrier" ::: "memory");
        { int t = threadIdx.x; asm volatile("" : "+v"(t)); if (t < BM) { const f32x4 v = *(const PG8_LAS f32x4*)(X + t * 4); part[(size_t)(u.pm * BM + t) * 8 + u.pn] = (v[0] + v[1]) + (v[2] + v[3]); } }
    }
};
template <class Epi, class Sched, bool ALIGN_EPI = false, bool SP2 = false>
__device__ __forceinline__ void gemm_phase(PG8_LAS unsigned char* lds, const Gemm g, const Sched& S, const Epi& E) {
    int tid_raw = threadIdx.x; asm volatile("" : "+v"(tid_raw));
    const int tid = tid_raw, wid = __builtin_amdgcn_readfirstlane(tid >> 6), lane = tid & 63, wr = wid >> 2, wc = wid & 3, fr = lane & 15, fq = lane >> 4;
    const int K = g.K, nt = K / BK;
    unsigned voffA[2], voffB[2];
#pragma unroll
    for (int i = 0; i < 2; ++i) { int R, C; stage_rc(tid * 16 + i * 8192, R, C); const int Rb = Epi::PERM ? ((R & ~31) + perm32(R & 31)) : R;
        voffA[i] = (unsigned)(R * K + C) * 2u; voffB[i] = (unsigned)(Rb * K + C) * 2u; }
    const size_t kstep = (size_t)(BK * 2);
    const size_t hstep = (size_t)HALF * K * 2;
    const size_t tstep = 2 * hstep;
    const unsigned ldsw = (unsigned)wid * 1024u;
    const int aoff = lds_byte(wr * 64 + fr, fq * 8), boff = lds_byte(wc * 32 + fr, fq * 8);
#define PG8_SA(b, h) (((b) * 2 + (h)) * HTB)
#define PG8_SB(b, h) ((4 + (b) * 2 + (h)) * HTB)
#ifndef PG8_AUX_voffA
#define PG8_AUX_voffA 0
#endif
#ifndef PG8_AUX_voffB
#define PG8_AUX_voffB 0
#endif
#define PG8_STAGE(bufoff, gbase, voff) do { _Pragma("unroll") for (int _i = 0; _i < 2; ++_i) \
        __builtin_amdgcn_global_load_lds((const unsigned*)((const char*)(gbase) + (voff)[_i]), (PG8_LAS unsigned*)(lds + (bufoff) + ldsw + _i * 8192), 16, 0, PG8_AUX_##voff); } while (0)
#define PG8_LDA(dst, b, h) do { _Pragma("unroll") for (int m = 0; m < 4; ++m) _Pragma("unroll") for (int k = 0; k < 2; ++k) dst[m][k] = *(const PG8_LAS bf16x8*)(lds + PG8_SA(b, h) + aoff + m * 2048 + k * 1024); } while (0)
#define PG8_LDB(dst, b, h) do { _Pragma("unroll") for (int n = 0; n < 2; ++n) _Pragma("unroll") for (int k = 0; k < 2; ++k) dst[n][k] = *(const PG8_LAS bf16x8*)(lds + PG8_SB(b, h) + boff + n * 2048 + k * 1024); } while (0)
#define PG8_MMA(ai, bj, At, Bt) do { __builtin_amdgcn_s_setprio(1); _Pragma("unroll") for (int m = 0; m < 4; ++m) _Pragma("unroll") for (int n = 0; n < 2; ++n) _Pragma("unroll") for (int k = 0; k < 2; ++k) \
        acc[ai][bj][m][n] = __builtin_amdgcn_mfma_f32_16x16x32_bf16(Bt[n][k], At[m][k], acc[ai][bj][m][n], 0, 0, 0); __builtin_amdgcn_s_setprio(0); } while (0)
#define PG8_WAIT_V(n) asm volatile("s_waitcnt vmcnt(" #n ")" ::: "memory")
#define PG8_WAIT_L(n) asm volatile("s_waitcnt lgkmcnt(" #n ")" ::: "memory")
#define PG8_BAR __builtin_amdgcn_s_barrier()
#define PG8_SCHED __builtin_amdgcn_sched_barrier(0)
    Unit cur, nxt; int ui = 0;
    if (!S.next(0, cur)) return;
    f32x4 acc[2][2][4][2];
#pragma unroll
    for (int a = 0; a < 2; ++a)
#pragma unroll
        for (int b = 0; b < 2; ++b)
#pragma unroll
            for (int m = 0; m < 4; ++m)
#pragma unroll
                for (int n = 0; n < 2; ++n) acc[a][b][m][n] = (f32x4){0.f, 0.f, 0.f, 0.f};
    bf16x8 At[4][2], B0[2][2], B1[2][2];
    const char* cA = (const char*)g.A + (size_t)cur.pm * tstep; const char* cB = (const char*)g.Bt + (size_t)cur.pn * tstep;
    S.a_ready(cur);
    if constexpr (SP2) {
        PG8_STAGE(PG8_SB(0, 0), cB, voffB); PG8_STAGE(PG8_SB(0, 1), cB + hstep, voffB); PG8_STAGE(PG8_SA(0, 0), cA, voffA); PG8_STAGE(PG8_SA(0, 1), cA + hstep, voffA);
        if (wr == 1) PG8_BAR;
        PG8_WAIT_V(2); PG8_BAR;
        PG8_STAGE(PG8_SB(1, 0), cB + kstep, voffB); PG8_STAGE(PG8_SA(1, 0), cA + kstep, voffA); PG8_STAGE(PG8_SB(1, 1), cB + hstep + kstep, voffB);
        PG8_WAIT_V(6); PG8_BAR;
    } else {
        PG8_STAGE(PG8_SB(0, 0), cB, voffB); PG8_STAGE(PG8_SA(0, 0), cA, voffA); PG8_STAGE(PG8_SB(0, 1), cB + hstep, voffB); PG8_STAGE(PG8_SA(0, 1), cA + hstep, voffA);
        if (wr == 1) PG8_BAR;
        PG8_WAIT_V(4); PG8_BAR;
        PG8_STAGE(PG8_SB(1, 0), cB + kstep, voffB); PG8_STAGE(PG8_SA(1, 0), cA + kstep, voffA); PG8_STAGE(PG8_SB(1, 1), cB + hstep + kstep, voffB);
        PG8_WAIT_V(6); PG8_BAR;
    }
    for (;;) {
        const bool has_next = S.next(ui + 1, nxt);
        const char* nA = has_next ? (const char*)g.A + (size_t)nxt.pm * tstep : cA; const char* nB = has_next ? (const char*)g.Bt + (size_t)nxt.pn * tstep : cB;
        for (int t = 0; t < nt; t += 2) {
            const bool last = (t == nt - 2);
            const char* a1 = cA + (size_t)(t + 1) * kstep;
            const char* a2 = last ? nA : cA + (size_t)(t + 2) * kstep; const char* b2 = last ? nB : cB + (size_t)(t + 2) * kstep;
            const char* a3 = a2 + kstep; const char* b3 = b2 + kstep;
            if (last && has_next) S.a_ready(nxt);
            if constexpr (SP2) {
            PG8_LDB(B0, 0, 0); PG8_LDB(B1, 0, 1); PG8_SCHED; PG8_LDA(At, 0, 0); PG8_STAGE(PG8_SA(1, 1), a1 + hstep, voffA);
            PG8_WAIT_V(8); PG8_WAIT_L(0); PG8_BAR; PG8_MMA(0, 0, At, B0); PG8_MMA(0, 1, At, B1); PG8_BAR; PG8_SCHED;
            PG8_LDA(At, 0, 1); PG8_STAGE(PG8_SB(0, 0), b2, voffB); PG8_STAGE(PG8_SB(0, 1), b2 + hstep, voffB); PG8_STAGE(PG8_SA(0, 0), a2, voffA);
            PG8_WAIT_V(8); PG8_WAIT_L(0); PG8_BAR; PG8_MMA(1, 0, At, B0); PG8_MMA(1, 1, At, B1); PG8_BAR; PG8_SCHED;
            PG8_LDB(B0, 1, 0); PG8_LDB(B1, 1, 1); PG8_SCHED; PG8_LDA(At, 1, 0); PG8_STAGE(PG8_SA(0, 1), a2 + hstep, voffA);
            PG8_WAIT_V(8); PG8_WAIT_L(0); PG8_BAR; PG8_MMA(0, 0, At, B0); PG8_MMA(0, 1, At, B1); PG8_BAR; PG8_SCHED;
            PG8_LDA(At, 1, 1); PG8_STAGE(PG8_SB(1, 0), b3, voffB); PG8_STAGE(PG8_SB(1, 1), b3 + hstep, voffB); PG8_STAGE(PG8_SA(1, 0), a3, voffA);
            PG8_WAIT_V(8); PG8_WAIT_L(0); PG8_BAR; PG8_MMA(1, 0, At, B0); PG8_MMA(1, 1, At, B1); PG8_BAR; PG8_SCHED;
            } else {
            PG8_LDB(B0, 0, 0); PG8_SCHED; PG8_LDA(At, 0, 0); PG8_STAGE(PG8_SA(1, 1), a1 + hstep, voffA);
            PG8_WAIT_L(8); PG8_BAR; PG8_WAIT_L(0); PG8_MMA(0, 0, At, B0); PG8_BAR; PG8_SCHED;
            PG8_LDB(B1, 0, 1); PG8_STAGE(PG8_SB(0, 0), b2, voffB);
            PG8_BAR; PG8_WAIT_L(0); PG8_MMA(0, 1, At, B1); PG8_BAR;
            PG8_LDA(At, 0, 1); PG8_STAGE(PG8_SA(0, 0), a2, voffA);
            PG8_BAR; PG8_WAIT_L(0); PG8_MMA(1, 0, At, B0); PG8_BAR; PG8_SCHED;
            PG8_STAGE(PG8_SB(0, 1), b2 + hstep, voffB);
            PG8_WAIT_V(6); PG8_BAR; PG8_MMA(1, 1, At, B1); PG8_BAR;
            PG8_LDB(B0, 1, 0); PG8_SCHED; PG8_LDA(At, 1, 0); PG8_STAGE(PG8_SA(0, 1), a2 + hstep, voffA);
            PG8_WAIT_L(8); PG8_BAR; PG8_WAIT_L(0); PG8_MMA(0, 0, At, B0); PG8_BAR; PG8_SCHED;
            PG8_LDB(B1, 1, 1); PG8_STAGE(PG8_SB(1, 0), b3, voffB);
            PG8_BAR; PG8_WAIT_L(0); PG8_MMA(0, 1, At, B1); PG8_BAR;
            PG8_LDA(At, 1, 1); PG8_STAGE(PG8_SA(1, 0), a3, voffA);
            PG8_BAR; PG8_WAIT_L(0); PG8_MMA(1, 0, At, B0); PG8_BAR; PG8_SCHED;
            PG8_STAGE(PG8_SB(1, 1), b3 + hstep, voffB);
            PG8_WAIT_V(6); PG8_BAR; PG8_MMA(1, 1, At, B1); PG8_BAR;
            }
        }
        if constexpr (ALIGN_EPI) { if (wr == 0) PG8_BAR; }
        if constexpr (!Epi::AFTER_DRAIN) { E(acc, cur, wr, wc, fr, fq); S.done(cur); }
        if (!has_next) break;
#pragma unroll
        for (int a = 0; a < 2; ++a)
#pragma unroll
            for (int b = 0; b < 2; ++b)
#pragma unroll
                for (int m = 0; m < 4; ++m)
#pragma unroll
                    for (int n = 0; n < 2; ++n) acc[a][b][m][n] = (f32x4){0.f, 0.f, 0.f, 0.f};
        cur = nxt; cA = nA; cB = nB; ++ui;
        if constexpr (ALIGN_EPI) { if (wr == 1) PG8_BAR; }
    }
    PG8_WAIT_V(0);
    if constexpr (!ALIGN_EPI) { if (wr == 0) PG8_BAR; }
    PG8_BAR;
    if constexpr (Epi::AFTER_DRAIN) { E.fused(acc, cur, wr, wc, fr, fq, lds, wid, lane); S.done(cur); }
#undef PG8_SA
#undef PG8_SB
#undef PG8_STAGE
#undef PG8_LDA
#undef PG8_LDB
#undef PG8_MMA
#undef PG8_WAIT_V
#undef PG8_WAIT_L
#undef PG8_BAR
#undef PG8_SCHED
}
}
namespace att {
typedef unsigned short bf16;
typedef short bf16x8 __attribute__((ext_vector_type(8)));
typedef short s16x4 __attribute__((ext_vector_type(4)));
typedef float f32x16 __attribute__((ext_vector_type(16)));
typedef float f32x4 __attribute__((ext_vector_type(4)));
typedef unsigned u32x4 __attribute__((ext_vector_type(4)));
constexpr int D = 128, PQ = 128, PO = 2048, SEQ = 8192;
constexpr size_t SECB = (size_t)32 * 8192 * 128 * 2;
constexpr float THR = 8.f, LOG2E = 1.4426950408889634f;
constexpr int NW = 8, QBLK = 32, KVBLK = 64, QB = NW * QBLK;
constexpr int SHM_V = KVBLK * D * 2, SHM_K = KVBLK * D * 2;
constexpr int OFF_WS = 2 * SHM_V + 2 * SHM_K, OFF_CB = OFF_WS + NW * 64 * 4, LDS_BYTES = OFF_CB + SEQ * 4;
#define KSWZ(row, colB) ((row) * 256 + ((colB) ^ (((row) & 7) << 4)))
#define SBAR() __builtin_amdgcn_sched_barrier(0)
__device__ __forceinline__ int v_st(int k, int c) { const int kk = (k & ~0xC) | ((k & 4) << 1) | ((k & 8) >> 1); return ((kk >> 3) * 4 + (c >> 5)) * 512 + ((kk & 7) * 32 + (c & 31)) * 2; }
__device__ __forceinline__ int v_rd_base(int lane) { return ((lane & 3) << 3) | (((lane >> 2) & 3) << 6) | (((lane >> 4) & 1) << 5) | (((lane >> 5) & 1) << 8); }
constexpr int v_rd_off(int d0, int ks, int half) { return d0 * 512 + ks * 4096 + half * 2048; }
__device__ __forceinline__ int crow(int r, int hi) { return (r & 3) + 8 * (r >> 2) + 4 * hi; }
__device__ __forceinline__ unsigned cvtpk(float lo, float hi) { unsigned r; asm volatile("v_cvt_pk_bf16_f32 %0, %1, %2" : "=v"(r) : "v"(lo), "v"(hi)); return r; }
__device__ __forceinline__ bf16x8 ld8(const bf16* p) { return *reinterpret_cast<const bf16x8*>(p); }
__device__ __forceinline__ void mask_tile(f32x16& p0, f32x16& p1, int dq) {
    const float NEG = -__builtin_inff();
#pragma unroll
    for (int r = 0; r < 16; ++r) { const int c = (r & 3) + 8 * (r >> 2); if (dq - c < 0) p0[r] = NEG; if (dq - c - 32 < 0) p1[r] = NEG; }
}
__device__ __forceinline__ void partialSM(f32x16& p0, f32x16& p1, float& m_reg, float& mn, float& alpha) {
    float pmax = p0[0];
#pragma unroll
    for (int r = 1; r < 16; ++r) pmax = fmaxf(pmax, p0[r]);
#pragma unroll
    for (int r = 0; r < 16; ++r) pmax = fmaxf(pmax, p1[r]);
    { auto rr = __builtin_amdgcn_permlane32_swap(__float_as_uint(pmax), __float_as_uint(pmax), false, false); pmax = fmaxf(__uint_as_float(rr[0]), __uint_as_float(rr[1])); }
    if (__builtin_expect(__all((pmax - m_reg) <= THR), 1)) { mn = m_reg; alpha = 1.f; }
    else { mn = fmaxf(m_reg, pmax); alpha = __builtin_amdgcn_exp2f(m_reg - mn); m_reg = mn; }
#pragma unroll
    for (int r = 0; r < 16; ++r) { p0[r] -= mn; p1[r] -= mn; }
#pragma unroll
    for (int r = 0; r < 16; ++r) p0[r] = __builtin_amdgcn_exp2f(p0[r]);
}
__device__ __forceinline__ void finishSM(f32x16& p0, f32x16& p1, float alpha, float& l_reg, bf16x8& pa0, bf16x8& pa1, bf16x8& pa2, bf16x8& pa3) {
#pragma unroll
    for (int r = 0; r < 16; ++r) p1[r] = __builtin_amdgcn_exp2f(p1[r]);
    float ps = 0;
#pragma unroll
    for (int r = 0; r < 16; ++r) ps += p0[r];
#pragma unroll
    for (int r = 0; r < 16; ++r) ps += p1[r];
    { auto rr = __builtin_amdgcn_permlane32_swap(__float_as_uint(ps), __float_as_uint(ps), false, false); ps = __uint_as_float(rr[0]) + __uint_as_float(rr[1]); }
    l_reg = l_reg * alpha + ps;
#define PK4(P, B_, OUT) do { unsigned a0 = cvtpk(P[B_+0], P[B_+1]), a1 = cvtpk(P[B_+2], P[B_+3]);                          \
        unsigned b0 = cvtpk(P[B_+4], P[B_+5]), b1 = cvtpk(P[B_+6], P[B_+7]);                                             \
        auto r0 = __builtin_amdgcn_permlane32_swap(a0, b0, false, false); auto r1 = __builtin_amdgcn_permlane32_swap(a1, b1, false, false); \
        u32x4 w = {r0[0], r1[0], r0[1], r1[1]}; OUT = *reinterpret_cast<bf16x8*>(&w); } while (0)
    PK4(p0, 0, pa0); PK4(p0, 8, pa1); PK4(p1, 0, pa2); PK4(p1, 8, pa3);
#undef PK4
}
__device__ __forceinline__ void bias_init(f32x16& p0, f32x16& p1, const float* cb_t, int hi) {
    const float* cb = cb_t + 4 * hi;
    const f32x4 a0 = *(const f32x4*)(cb), a1 = *(const f32x4*)(cb + 8), a2 = *(const f32x4*)(cb + 16), a3 = *(const f32x4*)(cb + 24);
    const f32x4 b0 = *(const f32x4*)(cb + 32), b1 = *(const f32x4*)(cb + 40), b2 = *(const f32x4*)(cb + 48), b3 = *(const f32x4*)(cb + 56);
    p0 = (f32x16){a0[0], a0[1], a0[2], a0[3], a1[0], a1[1], a1[2], a1[3], a2[0], a2[1], a2[2], a2[3], a3[0], a3[1], a3[2], a3[3]};
    p1 = (f32x16){b0[0], b0[1], b0[2], b0[3], b1[0], b1[1], b1[2], b1[3], b2[0], b2[1], b2[2], b2[3], b3[0], b3[1], b3[2], b3[3]};
}
template <int KB>
__device__ __forceinline__ void qkt(f32x16& p0, f32x16& p1, const char* K_lds, int r32, int hi, const bf16x8* qr) {
    const char* kb[4];
#pragma unroll
    for (int dd = 0; dd < 4; ++dd) kb[dd] = K_lds + KB * SHM_K + KSWZ(r32, (dd * 16 + hi * 8) * 2);
#pragma unroll
    for (int d0 = 0; d0 < 8; ++d0) { const char* a = kb[d0 & 3] + (d0 >> 2) * 128;
        bf16x8 b0 = *reinterpret_cast<const bf16x8*>(a);
        bf16x8 b1 = *reinterpret_cast<const bf16x8*>(a + 32 * 256);
        p0 = __builtin_amdgcn_mfma_f32_32x32x16_bf16(b0, qr[d0], p0, 0, 0, 0);
        p1 = __builtin_amdgcn_mfma_f32_32x32x16_bf16(b1, qr[d0], p1, 0, 0, 0); }
}
template <int VB>
__device__ __forceinline__ void pv_tile(f32x16* o, int vb0, bf16x8 pa0, bf16x8 pa1, bf16x8 pa2, bf16x8 pa3) {
#define TRRD(dst, off) asm volatile("ds_read_b64_tr_b16 %0, %1 offset:%2" : "=&v"(dst) : "v"(vb0), "i"(off) : "memory")
#define PV_D0(d0) do { s16x4 l0, l1, l2, l3, h0, h1, h2, h3; constexpr int b_ = VB * SHM_V + v_rd_off(d0, 0, 0); \
        TRRD(l0, b_); TRRD(h0, b_ + 2048); TRRD(l1, b_ + 4096); TRRD(h1, b_ + 6144); TRRD(l2, b_ + 8192); TRRD(h2, b_ + 10240); TRRD(l3, b_ + 12288); TRRD(h3, b_ + 14336); \
        asm volatile("s_waitcnt lgkmcnt(0)" ::: "memory"); SBAR();   \
        o[d0] = __builtin_amdgcn_mfma_f32_32x32x16_bf16(pa0, (bf16x8){l0[0], l0[1], l0[2], l0[3], h0[0], h0[1], h0[2], h0[3]}, o[d0], 0, 0, 0);   \
        o[d0] = __builtin_amdgcn_mfma_f32_32x32x16_bf16(pa1, (bf16x8){l1[0], l1[1], l1[2], l1[3], h1[0], h1[1], h1[2], h1[3]}, o[d0], 0, 0, 0);   \
        o[d0] = __builtin_amdgcn_mfma_f32_32x32x16_bf16(pa2, (bf16x8){l2[0], l2[1], l2[2], l2[3], h2[0], h2[1], h2[2], h2[3]}, o[d0], 0, 0, 0);   \
        o[d0] = __builtin_amdgcn_mfma_f32_32x32x16_bf16(pa3, (bf16x8){l3[0], l3[1], l3[2], l3[3], h3[0], h3[1], h3[2], h3[3]}, o[d0], 0, 0, 0); } while (0)
    PV_D0(0); PV_D0(1); PV_D0(2); PV_D0(3);
#undef PV_D0
#undef TRRD
}
struct BlockRef { unsigned qoff, koff, ooff; int P0; int bh; };
struct Seam { bf16x8 qr[8]; bf16x8 st_v0, st_v1, st_k0, st_k1; };
#define GAS1 __attribute__((address_space(1)))
#define LDO(base, boff) (*(const GAS1 bf16x8*)((const GAS1 char*)(base) + (boff)))
#define VMW() asm volatile("s_waitcnt vmcnt(0)" ::: "memory")
#define VMWN(n) asm volatile("s_waitcnt vmcnt(%0)" :: "i"(n) : "memory")
#define OPQ(p) asm volatile("" : "+s"(p))
#define SLOAD_H(Kp, k0) do { const char* kt_ = (Kp) + (size_t)(k0) * (PQ * 2); OPQ(kt_); const char* vt_ = kt_ + SECB; OPQ(vt_); unsigned o0_ = so0, o1_ = so1; asm volatile("" : "+v"(o0_), "+v"(o1_));            \
                         S.st_v0 = LDO(vt_, o0_); S.st_v1 = LDO(vt_, o1_); S.st_k0 = LDO(kt_, o0_); S.st_k1 = LDO(kt_, o1_); } while (0)
#define SWRITE_HK(bf) do { *(bf16x8*)(K_lds + (bf) * SHM_K + kws) = S.st_k0; *(bf16x8*)(K_lds + (bf) * SHM_K + kws + 32 * 256) = S.st_k1; } while (0)
#define SWRITE_HV(bf) do { *(bf16x8*)(V_lds + (bf) * SHM_V + vst0) = S.st_v0; *(bf16x8*)(V_lds + (bf) * SHM_V + vst1) = S.st_v1; } while (0)
#define SWRITE_H(bf) do { SWRITE_HV(bf); SWRITE_HK(bf); } while (0)
__device__ __forceinline__ void prime(const BlockRef& cur, const char* QKVb, char* lds, Seam& S) {
    int tid_raw = threadIdx.x; asm volatile("" : "+v"(tid_raw));
    const int tid = tid_raw, wid = __builtin_amdgcn_readfirstlane(tid >> 6), lane = tid & 63, r32 = lane & 31, hi = lane >> 5;
    const int sr = tid >> 4, sc = (tid & 15) * 8, kws = KSWZ(sr, sc * 2); char* K_lds = lds + 2 * SHM_V;
    const unsigned so0 = (unsigned)(sr * PQ + sc) * 2u, so1 = so0 + 32u * PQ * 2u, qo = (unsigned)(r32 * PQ + hi * 8) * 2u;
    { const char* qb_ = QKVb + cur.qoff + (size_t)(wid * QBLK) * PQ * 2; OPQ(qb_); unsigned qo_ = qo; asm volatile("" : "+v"(qo_));
#pragma unroll
    for (int d0 = 0; d0 < 8; ++d0) S.qr[d0] = LDO(qb_, qo_ + d0 * 32); }
    { const char* Kh = QKVb + cur.koff; SLOAD_H(Kh, 0); } VMW(); SWRITE_HK(0);
    __syncthreads();
}
__device__ __forceinline__ void block(const BlockRef& cur, const BlockRef& nxt, const char* QKVb, char* OBb, char* lds, Seam& S) {
    int tid_raw = threadIdx.x; asm volatile("" : "+v"(tid_raw));
    const int tid = tid_raw, wid = __builtin_amdgcn_readfirstlane(tid >> 6), lane = tid & 63, r32 = lane & 31, hi = lane >> 5;
    const int NT = (cur.P0 + QB) / KVBLK;
    const int qlo = cur.P0 + wid * QBLK, qm = qlo + r32 - 4 * hi;
    char* V_lds = lds; char* K_lds = lds + 2 * SHM_V;
    float* ws = (float*)(lds + OFF_WS) + wid * 64; float* li_l = ws, * al_l = ws + 32; const float* cb_l = (const float*)(lds + OFF_CB);
    float m_reg = -1e30f, l_reg = 0; f32x16 o[4] = {};
    const int sr = tid >> 4, sc = (tid & 15) * 8, vst0 = v_st(sr, sc), vst1 = v_st(32 + sr, sc), kws = KSWZ(sr, sc * 2);
    const unsigned so0 = (unsigned)(sr * PQ + sc) * 2u, so1 = so0 + 32u * PQ * 2u, qo = (unsigned)(r32 * PQ + hi * 8) * 2u;
    const int vb0 = (int)(uintptr_t)V_lds + v_rd_base(lane);
    const char* Kh = QKVb + cur.koff;
#define RESC(a) do { if (__any((a) < 1.f)) { if (hi == 0) al_l[r32] = (a); asm volatile("s_waitcnt lgkmcnt(0)" ::: "memory");              \
                     for (int d_ = 0; d_ < 4; ++d_) for (int r = 0; r < 16; ++r) o[d_][r] *= al_l[crow(r, hi)]; } } while (0)
#define KBASE(t) ((t) * KVBLK)
#define MASKT(P0_, P1_, t) do { const int kb_ = KBASE(t); if (kb_ + KVBLK - 1 > qlo) mask_tile(P0_, P1_, qm - kb_); } while (0)
#define SEAM_K0() do { VMWN(8); SWRITE_HK(0); SBAR(); } while (0)
    f32x16 pA0, pA1, pB0, pB1; float mnA, mnB, alA, alB; bf16x8 pa0, pa1, pa2, pa3;
    SWRITE_HV(0); SBAR();
    if (NT > 1) { SLOAD_H(Kh, KBASE(1)); }
    bias_init(pA0, pA1, cb_l, hi);
    SBAR(); qkt<0>(pA0, pA1, K_lds, r32, hi, S.qr);
    if (NT > 1) bias_init(pB0, pB1, cb_l + KBASE(1), hi);
    MASKT(pA0, pA1, 0); partialSM(pA0, pA1, m_reg, mnA, alA);
    if (NT > 1) { VMW(); SWRITE_H(1); }
    __syncthreads();
#define HALF_STEP(PX0, PX1, mnX, alX, PY0, PY1, alY, t, KB, VB, SB) do {                                                      \
        SBAR(); if ((t) + 1 < NT) { SLOAD_H(Kh, KBASE((t) + 1)); SBAR(); }         \
        qkt<KB>(PX0, PX1, K_lds, r32, hi, S.qr);                                                                              \
        finishSM(PY0, PY1, alY, l_reg, pa0, pa1, pa2, pa3); SBAR();                                                           \
        if ((t) + 1 < NT) bias_init(PY0, PY1, cb_l + KBASE((t) + 1), hi);     \
        pv_tile<VB>(o, vb0, pa0, pa1, pa2, pa3); MASKT(PX0, PX1, (t)); partialSM(PX0, PX1, m_reg, mnX, alX);                  \
        __syncthreads();                                                                                                      \
        if ((t) + 1 < NT) { VMW(); SWRITE_H(SB); }                                                                      \
        RESC(alX); __syncthreads(); } while (0)
    for (int t = 1; t + 1 < NT; t += 2) {
        HALF_STEP(pB0, pB1, mnB, alB, pA0, pA1, alA, t, 1, 0, 0);
        HALF_STEP(pA0, pA1, mnA, alA, pB0, pB1, alB, t + 1, 0, 1, 1);
    }
    const bool even = (NT & 1) == 0;
    if (even) { SBAR(); qkt<1>(pB0, pB1, K_lds, r32, hi, S.qr); SBAR(); }
    { const char* Kn = QKVb + nxt.koff; SLOAD_H(Kn, 0); } SBAR();
    { const char* qb_ = QKVb + nxt.qoff + (size_t)(wid * QBLK) * PQ * 2; OPQ(qb_); unsigned qo_ = qo; asm volatile("" : "+v"(qo_));
#pragma unroll
    for (int d0 = 0; d0 < 8; ++d0) S.qr[d0] = LDO(qb_, qo_ + d0 * 32); }
    SBAR();
    finishSM(pA0, pA1, alA, l_reg, pa0, pa1, pa2, pa3); SBAR();
    pv_tile<0>(o, vb0, pa0, pa1, pa2, pa3);
    if (even) { MASKT(pB0, pB1, NT - 1); partialSM(pB0, pB1, m_reg, mnB, alB); __syncthreads(); RESC(alB);
        finishSM(pB0, pB1, alB, l_reg, pa0, pa1, pa2, pa3); SBAR(); pv_tile<1>(o, vb0, pa0, pa1, pa2, pa3); }
    SBAR(); SEAM_K0();
    if (hi == 0) li_l[r32] = l_reg; asm volatile("s_waitcnt lgkmcnt(0)" ::: "memory");
    float rli[16];
#pragma unroll
    for (int r = 0; r < 16; ++r) rli[r] = __builtin_amdgcn_rcpf(li_l[crow(r, hi)]);
    char* Ow = OBb + cur.ooff + (size_t)(wid * QBLK) * PO * 2; OPQ(Ow); unsigned oo = (unsigned)(4 * hi * PO + r32) * 2u; asm volatile("" : "+v"(oo));
#pragma unroll
    for (int r = 0; r < 16; ++r) { const unsigned orb = (unsigned)(((r & 3) + 8 * (r >> 2)) * PO) * 2u;
#pragma unroll
        for (int d0 = 0; d0 < 4; ++d0) { const float v = o[d0][r] * rli[r]; const float vn = __uint_as_float(__builtin_amdgcn_mov_dpp(__float_as_uint(v), 0xB1, 0xf, 0xf, true));
            if ((r32 & 1) == 0) *(GAS1 unsigned*)((GAS1 char*)Ow + (oo + orb + d0 * 64)) = cvtpk(v, vn); } }
    __syncthreads();
#undef RESC
#undef KBASE
#undef MASKT
#undef SEAM_K0
#undef HALF_STEP
}
#undef LDO
#undef GAS1
#undef OPQ
#undef VMW
#undef VMWN
#undef SLOAD_H
#undef SWRITE_HK
#undef SWRITE_HV
#undef SWRITE_H
__device__ __forceinline__ BlockRef make_ref(int L, int pass) {
    const int xcd = L & 7, k = L >> 3, bh = (k >> 4) * 8 + xcd, x = k & 15, qb = pass ? 31 - x : x, b = bh >> 4, h = bh & 15;
    BlockRef r; r.P0 = qb * QB; r.bh = bh;
    r.qoff = (unsigned)(((bh * SEQ + r.P0) * PQ) * 2); r.koff = (unsigned)(SECB + (size_t)(bh * SEQ) * PQ * 2); r.ooff = (unsigned)(((b * SEQ + r.P0) * PO + h * D) * 2);
    return r;
}
__device__ __forceinline__ void attn_phase(char* lds, const bf16* QKV, bf16* OB, const float* LP, const float* TT) {
    const int total = 512; int stride = gridDim.x, L = blockIdx.x; asm volatile("" : "+s"(stride), "+s"(L)); if (L >= total) return;
    int pass = 0; BlockRef cur = make_ref(L, 0); Seam S; int bh_lds = -1; const char* QKVb = (const char*)QKV; char* OBb = (char*)OB;
    prime(cur, QKVb, lds, S);
    for (;;) {
        if (cur.bh != bh_lds) {
            int t0_ = threadIdx.x; asm volatile("" : "+v"(t0_)); const int b_ = cur.bh >> 4, h_ = cur.bh & 15, ln_ = t0_ & 63, wv_ = t0_ >> 6;
            float* wt_ = (float*)(lds + OFF_WS); float* dst = (float*)(lds + OFF_CB);
            const float tt_ = TT[(size_t)(b_ * 512 + t0_) * 16 + h_]; float inc_ = tt_;
#pragma unroll
            for (int o_ = 1; o_ < 64; o_ <<= 1) { const float u_ = __shfl_up(inc_, o_); if (ln_ >= o_) inc_ += u_; }
            if (ln_ == 63) wt_[wv_] = inc_;
            __syncthreads();
            float off_ = inc_ - tt_; for (int w_ = 0; w_ < wv_; ++w_) off_ += wt_[w_];
            const float* lp_ = LP + ((size_t)b_ * SEQ + (size_t)t0_ * 16) * 16 + h_;
#pragma unroll
            for (int i = 0; i < 16; i += 4) { f32x4 v_ = {lp_[(i + 0) * 16], lp_[(i + 1) * 16], lp_[(i + 2) * 16], lp_[(i + 3) * 16]}; *(f32x4*)(dst + t0_ * 16 + i) = (v_ + off_) * (-LOG2E); }
            bh_lds = cur.bh; __syncthreads(); }
        const bool more_pass = pass == 0, more_item = L + stride < total, last = !more_pass && !more_item;
        int passn = pass + 1, Ln = L; if (!more_pass) { passn = 0; Ln = more_item ? L + stride : L; }
        const BlockRef nxt = last ? cur : make_ref(Ln, passn);
        block(cur, nxt, QKVb, OBb, lds, S);
        if (last) break;
        cur = nxt; pass = passn; L = Ln;
    }
}
#undef SBAR
#undef KSWZ
}
#define LAS __attribute__((address_space(3)))
typedef unsigned short bf16;
typedef unsigned v4u __attribute__((ext_vector_type(4)));
typedef unsigned v2u __attribute__((ext_vector_type(2)));
typedef float f32x4 __attribute__((ext_vector_type(4)));
typedef short bf16x8 __attribute__((ext_vector_type(8)));
constexpr int NWAVES = 8;
constexpr int M = 16384, DM = 2048, SEQ = 8192, NH = 16, HD = 128, FF = 8192, NQKV = 6144, NFOXW = 6160, NUV = 4096;
#ifndef NDEPTH
#define NDEPTH 4
#endif
constexpr int DEPTH = NDEPTH;
constexpr float EPS = 1e-6f;
constexpr size_t MiB = 1u << 20;
constexpr size_t WS_CTL = 0, WS_LF = 1 * MiB, WS_C = 2 * MiB, WS_XB = 4 * MiB, WS_FWIN = 68 * MiB, WS_FWOUT = 117 * MiB, WS_SWIN = 133 * MiB, WS_SWOUT = 165 * MiB,
                 WS_W1 = 181 * MiB, WS_W2 = 309 * MiB, WS_BIG = 437 * MiB, WS_SSQ = 693 * MiB, WS_END = 698 * MiB;
constexpr size_t FWIN_STRIDE = (size_t)NFOXW * DM;
constexpr int LDS_BYTES = 147456, LDS_X = 131072, LDS_MISC = 131072 + 8192;
static_assert(att::LDS_BYTES <= 131072 && pg8::STAGE_BYTES == 131072, "LDS map");

__device__ __forceinline__ unsigned pk2(float lo, float hi) { unsigned r; asm volatile("v_cvt_pk_bf16_f32 %0, %1, %2" : "=v"(r) : "v"(lo), "v"(hi)); return r; }
__device__ __forceinline__ float bf_lo(unsigned w) { return __uint_as_float(w << 16); }
__device__ __forceinline__ float bf_hi(unsigned w) { return __uint_as_float(w & 0xffff0000u); }
__device__ __forceinline__ float wave_sum(float v) {
#pragma unroll
    for (int o = 1; o < 64; o <<= 1) v += __shfl_xor(v, o);
    return v;
}
#define LDS_WAIT() asm volatile("s_waitcnt lgkmcnt(0)" ::: "memory")
__device__ __forceinline__ void p0_transpose_item(const float* W, int K, int N, const float* gain, bf16* WT, LAS float* scr, int item, int lane) {
    const int nblk = (N + 63) / 64, kb = item / nblk, nb = item % nblk, k0 = 64 * kb, n0 = 64 * nb;
    const int nl = lane & 15, kr = lane >> 4, nn = n0 + 4 * nl; const bool nok = nn < N;
    f32x4 v[16];
#pragma unroll
    for (int i = 0; i < 16; ++i) v[i] = nok ? *(const f32x4*)(W + (size_t)(k0 + 4 * i + kr) * N + nn) : (f32x4){0.f, 0.f, 0.f, 0.f};
#pragma unroll
    for (int i = 0; i < 16; ++i) { const int kk = 4 * i + kr; const float g = gain ? gain[k0 + kk] : 1.f; LAS float* d = scr + kk * 65 + 4 * nl;
        d[0] = v[i][0] * g; d[1] = v[i][1] * g; d[2] = v[i][2] * g; d[3] = v[i][3] * g; }
    LDS_WAIT(); asm volatile("" ::: "memory");
    const int c = lane & 7;
#pragma unroll
    for (int j = 0; j < 8; ++j) { const int n = (lane >> 3) + 8 * j; const LAS float* s = scr + (8 * c) * 65 + n;
        v4u o; o.x = pk2(s[0 * 65], s[1 * 65]); o.y = pk2(s[2 * 65], s[3 * 65]); o.z = pk2(s[4 * 65], s[5 * 65]); o.w = pk2(s[6 * 65], s[7 * 65]);
        if (n0 + n < N) *(v4u*)(WT + (size_t)(n0 + n) * K + k0 + 8 * c) = o; }
    LDS_WAIT(); asm volatile("" ::: "memory");
}
#define XB_TMO      128
#define XB_XCNT(j)  (256  + 64 * (j))
#define XB_XSUB(j)  (1280 + 64 * (j))
#define XB_XGEN(j)  (2304 + 64 * (j))
#define XB_TOP      3328
#define XB_TOPGEN   3392
#define XCD_BAR_WORDS 3456
#define XB_SPIN_CAP (1u << 18)

__device__ __forceinline__ unsigned xb_ld(unsigned* p)              { return __hip_atomic_load(p, __ATOMIC_RELAXED, __HIP_MEMORY_SCOPE_AGENT); }
__device__ __forceinline__ unsigned xb_add(unsigned* p, unsigned v) { return __hip_atomic_fetch_add(p, v, __ATOMIC_RELAXED, __HIP_MEMORY_SCOPE_AGENT); }
__device__ __forceinline__ unsigned xb_xcc_id() { return (unsigned)__builtin_amdgcn_s_getreg((3 << 11) | 20) & 0xFu; }
#define XB_SPIN(cond, bar) do { unsigned _sp = 0; while (cond) { __builtin_amdgcn_s_sleep(1); \
    if ((++_sp & 255u) == 0u) { if (xb_ld(&(bar)[XB_TMO])) break; if (_sp > XB_SPIN_CAP) { atomicAdd(&(bar)[XB_TMO], 1u); break; } } } } while (0)

struct XcdBarrier {
    unsigned* bar; unsigned x;
    volatile LAS unsigned* st;
};

__device__ __forceinline__ XcdBarrier xcd_barrier_post(unsigned* bar, volatile LAS unsigned* st) {
    XcdBarrier b; b.bar = bar; b.x = xb_xcc_id(); b.st = st;
    if (threadIdx.x == 0) (void)xb_add(&bar[XB_XCNT(b.x)], 1u);
    return b;
}
__device__ __forceinline__ void xcd_barrier_complete(unsigned* bar, unsigned x, unsigned& nloc, unsigned& nx) {
    const unsigned G = gridDim.x * gridDim.y * gridDim.z;
    unsigned sum, cnt, mine, sp = 0u;
    for (;;) {
        sum = 0u; cnt = 0u; mine = 0u;
#pragma unroll
        for (unsigned j = 0; j < 16; ++j) { const unsigned c = xb_ld(&bar[XB_XCNT(j)]); sum += c; cnt += (c > 0u) ? 1u : 0u; mine = (j == x) ? c : mine; }
        if (sum == G) break;
        __builtin_amdgcn_s_sleep(1);
        if ((++sp & 255u) == 0u) { if (xb_ld(&bar[XB_TMO])) break; if (sp > XB_SPIN_CAP) { atomicAdd(&bar[XB_TMO], 1u); break; } }
    }
    nloc = mine > 0u ? mine : 1u; nx = cnt > 0u ? cnt : 1u;
}

__device__ __forceinline__ void xcd_barrier(const XcdBarrier& b) {
    asm volatile("s_waitcnt vmcnt(0)" ::: "memory");
    __syncthreads();
    if (threadIdx.x == 0) {
        unsigned* bar = b.bar;
        __builtin_amdgcn_s_waitcnt(0);
        unsigned nloc = b.st[0], nx = b.st[1];
        if (nloc == 0u) { xcd_barrier_complete(bar, b.x, nloc, nx); b.st[0] = nloc; b.st[1] = nx; }
        const unsigned old = xb_add(&bar[XB_XSUB(b.x)], 1u);
        const unsigned gen = old / nloc;
        if (old + 1u == (gen + 1u) * nloc) {
            __builtin_amdgcn_fence(__ATOMIC_RELEASE, "agent");
            asm volatile("s_waitcnt vmcnt(0)" ::: "memory");
            const unsigned og = xb_add(&bar[XB_TOP], 1u);
            const unsigned tg = og / nx;
            if (og + 1u == (tg + 1u) * nx) xb_add(&bar[XB_TOPGEN], 1u);
            else XB_SPIN(xb_ld(&bar[XB_TOPGEN]) == tg, bar);
            __builtin_amdgcn_fence(__ATOMIC_ACQUIRE, "agent");
            xb_add(&bar[XB_XGEN(b.x)], 1u);
            asm volatile("s_waitcnt vmcnt(0)" ::: "memory");
        } else {
            XB_SPIN(xb_ld(&bar[XB_XGEN(b.x)]) == gen, bar);
            __builtin_amdgcn_fence(__ATOMIC_ACQUIRE, "agent");
            asm volatile("s_waitcnt vmcnt(0)" ::: "memory");
        }
    }
    __syncthreads();
}

struct Args {
    const float* x; const float* g_mix; const float* g_mlp; const float* fox_w_in; const float* fox_b_f; const float* fox_g_q; const float* fox_g_k; const float* fox_w_out;
    const float* sgu_w_in; const float* sgu_b_in; const float* sgu_g_v; const float* sgu_w_s; const float* sgu_b_s; const float* sgu_w_out; const float* mlp_w1; const float* mlp_w2;
    float* out; unsigned char* ws;
};

__global__ void __launch_bounds__(NWAVES * 64, 2) fwd_megakernel(Args a_unused) {
    extern __shared__ __attribute__((aligned(16))) unsigned char lds[];
    cg::grid_group grid = cg::this_grid();
    LAS unsigned char* ldsl = (LAS unsigned char*)lds;
#ifdef DBG_FENCE
#define GRID_SYNC() do { __threadfence(); grid.sync(); __threadfence(); } while (0)
#else
#define GRID_SYNC() do { asm volatile("s_waitcnt vmcnt(0)" ::: "memory"); grid.sync(); } while (0)
#endif
#define XSYNC() do { FRESH(kx_); XcdBarrier xb_; xb_.bar = (unsigned*)(kx_->ws + WS_CTL); xb_.x = xb_xcc_id(); xb_.st = (volatile LAS unsigned*)(ldsl + LDS_MISC); xcd_barrier(xb_); } while (0)
#define IDS() int tid = threadIdx.x, G = gridDim.x, bx = blockIdx.x; asm volatile("" : "+v"(tid), "+s"(G), "+s"(bx)); \
              const int lane = tid & 63, wave = __builtin_amdgcn_readfirstlane(tid >> 6), gw = bx * NWAVES + wave, NGW = G * NWAVES; (void)lane; (void)gw; (void)NGW
    typedef const __attribute__((address_space(4))) Args* KAp;
#define FRESH(ka) KAp ka = (KAp)__builtin_amdgcn_kernarg_segment_ptr(); asm volatile("" : "+s"(ka))
#define P_SSQ(ka) ((float*)((ka)->ws + WS_SSQ))
#define P_LF(ka) ((float*)((ka)->ws + WS_LF))
#define P_CUM(ka) ((float*)((ka)->ws + WS_C))
#define P_XB(ka) ((bf16*)((ka)->ws + WS_XB))
#define P_FWIN(ka) ((bf16*)((ka)->ws + WS_FWIN))
#define P_FWOUT(ka) ((bf16*)((ka)->ws + WS_FWOUT))
#define P_SWIN(ka) ((bf16*)((ka)->ws + WS_SWIN))
#define P_SWOUT(ka) ((bf16*)((ka)->ws + WS_SWOUT))
#define P_W1T(ka) ((bf16*)((ka)->ws + WS_W1))
#define P_W2T(ka) ((bf16*)((ka)->ws + WS_W2))
#define P_BIG(ka) ((bf16*)((ka)->ws + WS_BIG))
#define P_QKV(ka) P_BIG(ka)
#define P_OB(ka) (P_BIG(ka) + (size_t)M * NQKV)
#define P_UV(ka) P_BIG(ka)
#define P_GB(ka) (P_BIG(ka) + (size_t)M * NUV)
#define P_HB(ka) P_BIG(ka)

    { FRESH(a0_); if (threadIdx.x < 2) ((volatile LAS unsigned*)(ldsl + LDS_MISC))[threadIdx.x] = 0u;
      if (blockIdx.x == 0) { unsigned* cw = (unsigned*)(a0_->ws + WS_CTL); for (int i = threadIdx.x; i < XCD_BAR_WORDS; i += NWAVES * 64) cw[i] = 0u; }
      __syncthreads(); }
#ifdef DBG_LDSZERO
    { for (int i = threadIdx.x; i < LDS_BYTES / 16; i += NWAVES * 64) ((LAS v4u*)ldsl)[i] = (v4u){0u, 0u, 0u, 0u}; __syncthreads(); }
#endif
#ifndef REP_PRO
#define REP_PRO 1
#endif
    for (int rep_ = 0; rep_ < REP_PRO; ++rep_) {
        FRESH(a_); IDS();
        float* ssq = P_SSQ(a_); bf16* XB = P_XB(a_);
        bf16* FWIN = P_FWIN(a_); bf16* FWOUT = P_FWOUT(a_); bf16* SWIN = P_SWIN(a_); bf16* SWOUT = P_SWOUT(a_); bf16* W1T = P_W1T(a_); bf16* W2T = P_W2T(a_);
        LAS float* scr = (LAS float*)(ldsl + wave * 16640);
        constexpr int I_FWIN = (DM / 64) * ((NFOXW + 63) / 64), I_SQ = (DM / 64) * (DM / 64), I_SWIN = (DM / 64) * (NUV / 64), I_W1 = (DM / 64) * (FF / 64), I_W2 = (FF / 64) * (DM / 64);
        constexpr int NITEMS = 2 * I_FWIN + 2 * I_SQ + 2 * I_SWIN + 2 * I_SQ + 4 * I_W1 + 4 * I_W2;
        for (int it = gw; it < NITEMS; it += NGW) {
            int r = it;
            if (r < 2 * I_FWIN) { const int j = r / I_FWIN; r -= j * I_FWIN; p0_transpose_item(a_->fox_w_in + (size_t)j * DM * NFOXW, DM, NFOXW, a_->g_mix + (size_t)(2 * j) * DM, FWIN + (size_t)j * FWIN_STRIDE, scr, r, lane); continue; } r -= 2 * I_FWIN;
            if (r < 2 * I_SQ) { const int j = r / I_SQ; r -= j * I_SQ; p0_transpose_item(a_->fox_w_out + (size_t)j * DM * DM, DM, DM, nullptr, FWOUT + (size_t)j * DM * DM, scr, r, lane); continue; } r -= 2 * I_SQ;
            if (r < 2 * I_SWIN) { const int j = r / I_SWIN; r -= j * I_SWIN; p0_transpose_item(a_->sgu_w_in + (size_t)j * DM * NUV, DM, NUV, a_->g_mix + (size_t)(2 * j + 1) * DM, SWIN + (size_t)j * DM * NUV, scr, r, lane); continue; } r -= 2 * I_SWIN;
            if (r < 2 * I_SQ) { const int j = r / I_SQ; r -= j * I_SQ; p0_transpose_item(a_->sgu_w_out + (size_t)j * DM * DM, DM, DM, nullptr, SWOUT + (size_t)j * DM * DM, scr, r, lane); continue; } r -= 2 * I_SQ;
            if (r < 4 * I_W1) { const int j = r / I_W1; r -= j * I_W1; p0_transpose_item(a_->mlp_w1 + (size_t)j * DM * FF, DM, FF, a_->g_mlp + (size_t)j * DM, W1T + (size_t)j * DM * FF, scr, r, lane); continue; } r -= 4 * I_W1;
            { const int j = r / I_W2; r -= j * I_W2; p0_transpose_item(a_->mlp_w2 + (size_t)j * DM * FF, FF, DM, nullptr, W2T + (size_t)j * DM * FF, scr, r, lane); }
        }
        for (int m = gw; m < M; m += NGW) {
            const f32x4* xr = (const f32x4*)(a_->x + (size_t)m * DM) + lane; v2u* o8 = (v2u*)(XB + (size_t)m * DM) + lane; float s = 0.f;
#pragma unroll
            for (int j = 0; j < 8; ++j) { const f32x4 v = xr[64 * j]; s += (v[0] * v[0] + v[1] * v[1]) + (v[2] * v[2] + v[3] * v[3]); v2u w; w.x = pk2(v[0], v[1]); w.y = pk2(v[2], v[3]); o8[64 * j] = w; }
            s = wave_sum(s); if (lane == 0) { *(f32x4*)(ssq + (size_t)m * 8) = (f32x4){s, 0.f, 0.f, 0.f}; *(f32x4*)(ssq + (size_t)m * 8 + 4) = (f32x4){0.f, 0.f, 0.f, 0.f}; }
        }
    }
    GRID_SYNC();
    { FRESH(a1_); (void)xcd_barrier_post((unsigned*)(a1_->ws + WS_CTL), (volatile LAS unsigned*)(ldsl + LDS_MISC)); }
#ifndef WGM_G1F
#define WGM_G1F 4
#endif
#ifndef WGM_G1S
#define WGM_G1S 4
#endif
#ifndef WGM_G2
#define WGM_G2 4
#endif
#ifndef WGM_G3
#define WGM_G3 4
#endif
#ifndef WGM_G4
#define WGM_G4 4
#endif
    for (int layer = 0; layer < DEPTH; ++layer) {
        const int j = layer >> 1;
#define SSQ_MIX(ka) (P_SSQ(ka) + (size_t)(2 * layer) * M * 8)
#define SSQ_MLP(ka) (P_SSQ(ka) + (size_t)(2 * layer + 1) * M * 8)
#define SSQ_NXT(ka) (P_SSQ(ka) + (size_t)(2 * layer + 2) * M * 8)
        if ((layer & 1) == 0) {
#ifndef NO_GATE
#ifndef REP_GATE
#define REP_GATE 1
#endif
            for (int rep_ = 0; rep_ < REP_GATE; ++rep_) { FRESH(a); IDS(); const bf16* Win = P_FWIN(a) + (size_t)j * FWIN_STRIDE; const bf16* XB = P_XB(a); const float* ssq_mix = SSQ_MIX(a); float* LF = P_LF(a); const float* bfp = a->fox_b_f + j * NH;
            for (int task = gw; task < M / 16; task += NGW) {
                const int fr = lane & 15, kq = lane >> 4;
                const bf16* ap = Win + (size_t)(NQKV + fr) * DM + 8 * kq;
                const bf16* bp = XB + (size_t)(task * 16 + fr) * DM + 8 * kq;
                f32x4 acc = {0.f, 0.f, 0.f, 0.f};
#pragma unroll 8
                for (int kk = 0; kk < DM / 32; ++kk) acc = __builtin_amdgcn_mfma_f32_16x16x32_bf16(*(const bf16x8*)(ap + 32 * kk), *(const bf16x8*)(bp + 32 * kk), acc, 0, 0, 0);
                const int row = task * 16 + fr; const float rs = pg8::rstd_row(ssq_mix, row); f32x4 o;
#pragma unroll
                for (int e = 0; e < 4; ++e) { const float z = acc[e] * rs + bfp[4 * kq + e]; o[e] = fminf(z, 0.f) - log1pf(expf(-fabsf(z))); }
#pragma unroll
                for (int d = 1; d < 16; d <<= 1) { f32x4 t_; t_[0] = __shfl_up(o[0], d, 16); t_[1] = __shfl_up(o[1], d, 16); t_[2] = __shfl_up(o[2], d, 16); t_[3] = __shfl_up(o[3], d, 16); if (fr >= d) o += t_; }
                *(f32x4*)(LF + (size_t)row * 16 + 4 * kq) = o;
                if (fr == 15) *(f32x4*)(P_CUM(a) + (size_t)task * 16 + 4 * kq) = o;
            } }
#endif
#ifndef NO_G1F
#ifndef REP_G1F
#define REP_G1F 1
#endif
            for (int rep_ = 0; rep_ < REP_G1F; ++rep_) {
                FRESH(a); IDS(); pg8::Gemm g{P_XB(a), P_FWIN(a) + (size_t)j * FWIN_STRIDE, M, NQKV, DM}; pg8::StaticOrder S; S.init(M, NQKV, G, bx, WGM_G1F);
                #ifndef PROBE_QKVMODE
#define PROBE_QKVMODE 0
#endif
                pg8::EpiQKV E{P_QKV(a), SSQ_MIX(a), a->fox_g_q + j * HD, a->fox_g_k + j * HD, (LAS float*)(ldsl + LDS_X), (REP_G1F > 1 && rep_ == 0) ? PROBE_QKVMODE : 0};
                pg8::gemm_phase<pg8::EpiQKV, pg8::StaticOrder, true, true>(ldsl, g, S, E);
            }
#endif
            XSYNC();
#ifndef NO_ATT
#ifndef REP_ATT
#define REP_ATT 1
#endif
            for (int rep_ = 0; rep_ < REP_ATT; ++rep_) { FRESH(a); att::attn_phase((char*)lds, P_QKV(a), P_OB(a), P_LF(a), P_CUM(a)); }
#endif
            XSYNC();
        } else {
#ifndef NO_G1S
#ifndef REP_G1S
#define REP_G1S 1
#endif
            for (int rep_ = 0; rep_ < REP_G1S; ++rep_) {
                FRESH(a); IDS(); pg8::Gemm g{P_XB(a), P_SWIN(a) + (size_t)j * DM * NUV, M, NUV, DM}; pg8::StaticOrder S; S.init(M, NUV, G, bx, WGM_G1S);
                pg8::EpiAct<2> E{P_UV(a), NUV, a->sgu_b_in + (size_t)j * NUV, SSQ_MIX(a), 0};
                pg8::gemm_phase<pg8::EpiAct<2>, pg8::StaticOrder, true, true>(ldsl, g, S, E);
            }
#endif
            XSYNC();
#ifndef NO_SG
#ifndef REP_SG
#define REP_SG 1
#endif
            for (int rep_ = 0; rep_ < REP_SG; ++rep_) {
                FRESH(a); IDS(); const bf16* UV = P_UV(a); bf16* GB = P_GB(a); const float* g_v = a->sgu_g_v; const float* w_s = a->sgu_w_s; const float* b_s = a->sgu_b_s;
                LAS bf16* VT = (LAS bf16*)ldsl; constexpr int VP = 136;
                for (int unit = bx; unit < (M / 128) * 16; unit += G) {
                    const int ch = unit >> 4, gI = unit & 15;
                    {   const int s = tid >> 2, q4 = tid & 3;
                        const v4u* vp = (const v4u*)(UV + (size_t)(ch * 128 + s) * NUV + 2048 + gI * 128 + q4 * 32);
                        float f[32]; float ss = 0.f;
#pragma unroll
                        for (int c = 0; c < 4; ++c) { const v4u w = vp[c]; f[8 * c + 0] = bf_lo(w.x); f[8 * c + 1] = bf_hi(w.x); f[8 * c + 2] = bf_lo(w.y); f[8 * c + 3] = bf_hi(w.y);
                            f[8 * c + 4] = bf_lo(w.z); f[8 * c + 5] = bf_hi(w.z); f[8 * c + 6] = bf_lo(w.w); f[8 * c + 7] = bf_hi(w.w); }
#pragma unroll
                        for (int e = 0; e < 32; ++e) ss += f[e] * f[e];
                        ss += __shfl_xor(ss, 1); ss += __shfl_xor(ss, 2);
                        const float rv = __builtin_amdgcn_rsqf(ss * (1.0f / 128.0f) + EPS);
                        const float* gv = g_v + (size_t)j * DM + gI * 128 + q4 * 32;
#pragma unroll
                        for (int e = 0; e < 32; e += 2) { const unsigned w = pk2(f[e] * rv * gv[e], f[e + 1] * rv * gv[e + 1]);
                            VT[(q4 * 32 + e) * VP + s] = (bf16)(w & 0xffffu); VT[(q4 * 32 + e + 1) * VP + s] = (bf16)(w >> 16); }
                    }
                    __syncthreads();
                    {   const int fr = lane & 15, kq = lane >> 4, t = 16 * wave + fr, kmax = (16 * wave + 15) >> 5;
                        const float* wsrow = w_s + (((size_t)j * 16 + gI) * 128 + t) * 128;
                        bf16x8 bw[4];
#pragma unroll
                        for (int ks = 0; ks < 4; ++ks) { v4u w = {0u, 0u, 0u, 0u};
                            if (ks <= kmax) { const int s0 = 32 * ks + 8 * kq; const f32x4 lo = *(const f32x4*)(wsrow + s0), hi4 = *(const f32x4*)(wsrow + s0 + 4);
                                float e[8] = {lo[0], lo[1], lo[2], lo[3], hi4[0], hi4[1], hi4[2], hi4[3]};
#pragma unroll
                                for (int i = 0; i < 8; ++i) if (s0 + i > t) e[i] = 0.f;
                                w.x = pk2(e[0], e[1]); w.y = pk2(e[2], e[3]); w.z = pk2(e[4], e[5]); w.w = pk2(e[6], e[7]); }
                            bw[ks] = __builtin_bit_cast(bf16x8, w); }
                        const float bs = b_s[((size_t)j * 16 + gI) * 128 + t];
                        const size_t row = (size_t)ch * 128 + t;
                        v2u uws[8];
#pragma unroll
                        for (int nt = 0; nt < 8; ++nt) uws[nt] = *(const v2u*)(UV + row * NUV + gI * 128 + 16 * nt + 4 * kq);
#pragma unroll
                        for (int nt = 0; nt < 8; ++nt) { f32x4 acc = {0.f, 0.f, 0.f, 0.f};
#pragma unroll
                            for (int ks = 0; ks < 4; ++ks) if (ks <= kmax) { const bf16x8 av = *(const LAS bf16x8*)(VT + (16 * nt + fr) * VP + 32 * ks + 8 * kq);
                                acc = __builtin_amdgcn_mfma_f32_16x16x32_bf16(av, bw[ks], acc, 0, 0, 0); }
                            const int col = gI * 128 + 16 * nt + 4 * kq;
                            const v2u uw = uws[nt];
                            v2u o; o.x = pk2(bf_lo(uw.x) * (acc[0] + bs), bf_hi(uw.x) * (acc[1] + bs)); o.y = pk2(bf_lo(uw.y) * (acc[2] + bs), bf_hi(uw.y) * (acc[3] + bs));
                            *(v2u*)(GB + row * DM + col) = o; }
                    }
                    __syncthreads();
                }
            }
#endif
            XSYNC();
        }
#ifndef NO_G2
        {
            FRESH(a); IDS(); const bool fox = (layer & 1) == 0;
            const bf16* Amix = fox ? P_OB(a) : P_GB(a); const bf16* Wmix = (fox ? P_FWOUT(a) : P_SWOUT(a)) + (size_t)j * DM * DM;
            pg8::Gemm g{Amix, Wmix, M, DM, DM}; pg8::StaticOrder S; S.init(M, DM, G, bx, WGM_G2);
            pg8::EpiResid E{(layer == 0) ? a->x : (const float*)nullptr, (float*)nullptr, P_XB(a), SSQ_MLP(a), (LAS float*)(ldsl + LDS_X), (const float*)nullptr};
            pg8::gemm_phase<pg8::EpiResid, pg8::StaticOrder, true, true>(ldsl, g, S, E);
        }
#endif
        XSYNC();
#ifndef NO_G3
#ifndef REP_G3
#define REP_G3 1
#endif
#ifndef PROBE_NOSTORE
#define PROBE_NOSTORE 0
#endif
        for (int rep_ = 0; rep_ < REP_G3; ++rep_) {
            FRESH(a); IDS(); pg8::Gemm g{P_XB(a), P_W1T(a) + (size_t)layer * DM * FF, M, FF, DM}; pg8::StaticOrder S; S.init(M, FF, G, bx, WGM_G3);
            pg8::EpiAct<1> E{P_HB(a), FF, nullptr, SSQ_MLP(a), (REP_G3 > 1 && rep_ == 0 && PROBE_NOSTORE) ? 1 : 0};
            pg8::gemm_phase<pg8::EpiAct<1>, pg8::StaticOrder, true, true>(ldsl, g, S, E);
        }
#endif
        XSYNC();
#ifdef PROBE_G4D
        for (int rep_ = 0; rep_ < PROBE_G4D; ++rep_) {
            FRESH(a); IDS(); pg8::Gemm g{P_HB(a), P_W2T(a) + (size_t)layer * DM * FF, M, DM, FF}; pg8::StaticOrder S; S.init(M, DM, G, bx);
            pg8::EpiAct<1> E{P_HB(a), FF, nullptr, SSQ_MLP(a), 1};
            pg8::gemm_phase<pg8::EpiAct<1>, pg8::StaticOrder, true, true>(ldsl, g, S, E);
        }
#endif
#ifdef PROBE_G4R
        for (int rep_ = 0; rep_ < PROBE_G4R; ++rep_) {
            FRESH(a); IDS(); pg8::Gemm g{P_HB(a), P_W2T(a) + (size_t)layer * DM * FF, M, DM, FF}; pg8::StaticOrder S; S.init(M, DM, G, bx);
            pg8::EpiResid E{(const float*)nullptr, (float*)nullptr, (bf16*)(a->ws + 700 * MiB), (float*)(a->ws + 770 * MiB), (LAS float*)(ldsl + LDS_X), (const float*)SSQ_MLP(a)};
            pg8::gemm_phase<pg8::EpiResid, pg8::StaticOrder, true, true>(ldsl, g, S, E);
        }
#endif
#ifdef PROBE_G2R
        for (int rep_ = 0; rep_ < PROBE_G2R; ++rep_) {
            FRESH(a); IDS(); pg8::Gemm g{P_XB(a), P_FWOUT(a), M, DM, DM}; pg8::StaticOrder S; S.init(M, DM, G, bx);
            pg8::EpiResid E{(const float*)nullptr, (float*)nullptr, (bf16*)(a->ws + 700 * MiB), (float*)(a->ws + 770 * MiB), (LAS float*)(ldsl + LDS_X), (const float*)nullptr};
            pg8::gemm_phase<pg8::EpiResid, pg8::StaticOrder, true, true>(ldsl, g, S, E);
        }
#endif
#ifndef NO_G4
        {
            FRESH(a); IDS(); pg8::Gemm g{P_HB(a), P_W2T(a) + (size_t)layer * DM * FF, M, DM, FF}; pg8::StaticOrder S; S.init(M, DM, G, bx, WGM_G4);
            pg8::EpiResid E{(const float*)nullptr, (layer + 1 == DEPTH) ? a->out : (float*)nullptr, P_XB(a), SSQ_NXT(a), (LAS float*)(ldsl + LDS_X), (const float*)SSQ_MLP(a)};
            pg8::gemm_phase<pg8::EpiResid, pg8::StaticOrder, true, true>(ldsl, g, S, E);
        }
#endif
        if (layer + 1 < DEPTH) XSYNC();
    }
}

extern "C" void kernel_launch(void* const* d_in, const int* in_sizes, int n_in, void* d_out, int out_size, void* d_ws, size_t ws_size, hipStream_t stream) {
    static int grid = 0;
    if (grid == 0) {
        if (n_in != 16 || in_sizes[0] != M * DM || out_size != M * DM || ws_size < WS_END) { fprintf(stderr, "kernel_launch: unexpected shapes (n_in %d in0 %d out %d ws %zu)\n", n_in, n_in > 0 ? in_sizes[0] : -1, out_size, ws_size); grid = -1; return; }
        int dev = 0, cus = 0, per_cu = 0;
        (void)hipGetDevice(&dev); (void)hipDeviceGetAttribute(&cus, hipDeviceAttributeMultiprocessorCount, dev);
        if (hipFuncSetAttribute((const void*)fwd_megakernel, hipFuncAttributeMaxDynamicSharedMemorySize, LDS_BYTES) != hipSuccess) { fprintf(stderr, "kernel_launch: hipFuncSetAttribute failed\n"); grid = -1; return; }
        if (hipOccupancyMaxActiveBlocksPerMultiprocessor(&per_cu, (const void*)fwd_megakernel, NWAVES * 64, LDS_BYTES) != hipSuccess || per_cu < 1) { fprintf(stderr, "kernel_launch: occupancy query says %d\n", per_cu); per_cu = 1; }
        (void)hipGetLastError();
        grid = cus * 1;
        if (grid <= 0) grid = 256;
    }
    if (grid < 0) return;
    Args a{};
    a.x = (const float*)d_in[0]; a.g_mix = (const float*)d_in[1]; a.g_mlp = (const float*)d_in[2]; a.fox_w_in = (const float*)d_in[3]; a.fox_b_f = (const float*)d_in[4];
    a.fox_g_q = (const float*)d_in[5]; a.fox_g_k = (const float*)d_in[6]; a.fox_w_out = (const float*)d_in[7]; a.sgu_w_in = (const float*)d_in[8]; a.sgu_b_in = (const float*)d_in[9];
    a.sgu_g_v = (const float*)d_in[10]; a.sgu_w_s = (const float*)d_in[11]; a.sgu_b_s = (const float*)d_in[12]; a.sgu_w_out = (const float*)d_in[13]; a.mlp_w1 = (const float*)d_in[14]; a.mlp_w2 = (const float*)d_in[15];
    a.out = (float*)d_out; a.ws = (unsigned char*)d_ws;
#ifdef DBG_MEMSET
    (void)hipMemsetAsync(d_ws, 0x55, WS_END, stream); (void)hipMemsetAsync(d_out, 0x55, (size_t)M * DM * 4, stream);
#endif
    void* args[] = {&a};
    hipError_t e = hipLaunchCooperativeKernel((const void*)fwd_megakernel, dim3(grid), dim3(NWAVES * 64), args, LDS_BYTES, stream);
    if (e != hipSuccess) fprintf(stderr, "kernel_launch: cooperative launch failed: %s (grid %d)\n", hipGetErrorString(e), grid);
}
```

```cpp
#include <hip/hip_runtime.h>
#include <hip/hip_cooperative_groups.h>
#include <cstdio>
#include <cstdint>
namespace cg = cooperative_groups;
namespace pg8 {
#define PG8_LAS __attribute__((address_space(3)))
typedef unsigned short bf16_t;
typedef short bf16x8 __attribute__((ext_vector_type(8)));
typedef float f32x4 __attribute__((ext_vector_type(4)));
typedef unsigned u32x4 __attribute__((ext_vector_type(4)));
constexpr int BM = 256, BK = 64, HALF = 128, HTB = HALF * BK * 2  , STAGE_BYTES = 8 * HTB, NXCD = 8, WGM = 8;

__host__ __device__ __forceinline__ int lds_byte(int r, int c) { const int st = (r >> 4) * 2 + (c >> 5), rr = r & 15, cc = c & 31, ob = rr * 64 + cc * 2; return st * 1024 + (ob ^ (((ob >> 9) & 1) << 5)); }
__host__ __device__ __forceinline__ void stage_rc(int b, int& R, int& C) { const int st = b / 1024, sb = b % 1024, swz = sb ^ (((sb >> 9) & 1) << 5); R = (st >> 1) * 16 + swz / 64; C = (st & 1) * 32 + (swz % 64) / 2; }
__host__ __device__ __forceinline__ int perm32(int rho) { const int n = rho >> 4, i = rho & 15; return 8 * (i >> 2) + 4 * n + (i & 3); }

struct Unit { int pm, pn; };
struct Gemm { const bf16_t* A; const bf16_t* Bt; int M, N, K; };

struct StaticOrder {
    int nM, nN, nwg, G, c, wgm;
    __host__ __device__ void init(int M, int N, int G_, int c_, int wgm_ = WGM) { nM = M / BM; nN = N / BM; nwg = nM * nN; G = G_; c = c_; wgm = wgm_; }
    __host__ __device__ bool next(int i, Unit& u) const {
        const long L = (long)i * G + c; if (L >= nwg) return false;
        int wgid = (int)L; { const int q = nwg / NXCD, r = nwg % NXCD, xcd = wgid % NXCD, off = wgid / NXCD; wgid = (xcd < r ? xcd * (q + 1) : r * (q + 1) + (xcd - r) * q) + off; }
        const int nig = wgm * nN, gid = wgid / nig, fm = gid * wgm, gsz = (nM - fm) < wgm ? (nM - fm) : wgm;
        u.pm = fm + ((wgid % nig) % gsz); u.pn = (wgid % nig) / gsz; return true;
    }
    __device__ __forceinline__ void a_ready(const Unit&) const {}
    __device__ __forceinline__ void done(const Unit&) const {}
};

__device__ __forceinline__ unsigned cvt_pk_bf16(float lo, float hi) { unsigned r; asm volatile("v_cvt_pk_bf16_f32 %0, %1, %2" : "=v"(r) : "v"(lo), "v"(hi)); return r; }
typedef float f32x2 __attribute__((ext_vector_type(2)));
typedef unsigned u32x2 __attribute__((ext_vector_type(2)));
__device__ __forceinline__ float rstd_row(const float* part, int row) { const f32x4 a = *(const f32x4*)(part + (size_t)row * 8), b = *(const f32x4*)(part + (size_t)row * 8 + 4);
    return __builtin_amdgcn_rsqf((((a[0] + a[1]) + (a[2] + a[3])) + ((b[0] + b[1]) + (b[2] + b[3]))) * (1.0f / 2048.0f) + 1e-6f); }
__device__ __forceinline__ float act_relu2(float v) { const float r = fmaxf(v, 0.f); return r * r; }
__device__ __forceinline__ float act_gelu_tanh(float x) {
    const float u = 0.7978845608028654f * (x + 0.044715f * x * x * x);
    const float t = __builtin_amdgcn_exp2f(u * 2.8853900817779268f);
    return x - x * __builtin_amdgcn_rcpf(t + 1.0f);
}
#ifdef WT_STORES
__device__ __forceinline__ void st16(void* p, u32x4 w) { asm volatile("global_store_dwordx4 %0, %1, off sc0 sc1\n\ts_nop 1" :: "v"(p), "v"(w) : "memory"); }
#else
__device__ __forceinline__ void st16(void* p, u32x4 w) { *(u32x4*)p = w; }
#endif
template <int ACT> struct EpiAct {
    static constexpr bool PERM = true, AFTER_DRAIN = false;
    bf16_t* O; int ldc; const float* bias; const float* ssq; int nostore;
    __device__ __forceinline__ void operator()(const f32x4 (&acc)[2][2][4][2], const Unit& u, int wr, int wc, int fr, int fq) const {
        const int row0 = u.pm * BM + wr * 64 + fr; const int col0 = u.pn * BM + wc * 32 + 8 * fq;
        f32x4 bv[2][2];
#pragma unroll
        for (int bj = 0; bj < 2; ++bj)
#pragma unroll
            for (int n = 0; n < 2; ++n) bv[bj][n] = bias ? *(const f32x4*)(bias + col0 + bj * HALF + 4 * n) : (f32x4){0.f, 0.f, 0.f, 0.f};
#pragma unroll
        for (int ai = 0; ai < 2; ++ai)
#pragma unroll
            for (int m = 0; m < 4; ++m) { const int row = row0 + ai * HALF + m * 16; const float rs = (ACT == 1) ? 1.f : rstd_row(ssq, row); bf16_t* rowp = O + (size_t)row * ldc + col0;
#pragma unroll
                for (int bj = 0; bj < 2; ++bj) { f32x4 v0, v1;
                    if (ACT == 1) { const f32x4 a0 = acc[ai][bj][m][0], a1 = acc[ai][bj][m][1]; const float rs2 = rs * rs;
                        v0 = (f32x4){act_relu2(a0[0]), act_relu2(a0[1]), act_relu2(a0[2]), act_relu2(a0[3])} * rs2; v1 = (f32x4){act_relu2(a1[0]), act_relu2(a1[1]), act_relu2(a1[2]), act_relu2(a1[3])} * rs2; }
                    else { v0 = acc[ai][bj][m][0] * rs + bv[bj][0]; v1 = acc[ai][bj][m][1] * rs + bv[bj][1]; }
                    if (0) { v0 = (f32x4){act_relu2(v0[0]), act_relu2(v0[1]), act_relu2(v0[2]), act_relu2(v0[3])}; v1 = (f32x4){act_relu2(v1[0]), act_relu2(v1[1]), act_relu2(v1[2]), act_relu2(v1[3])}; }
                    if (ACT == 2) { v0 = (f32x4){act_gelu_tanh(v0[0]), act_gelu_tanh(v0[1]), act_gelu_tanh(v0[2]), act_gelu_tanh(v0[3])}; v1 = (f32x4){act_gelu_tanh(v1[0]), act_gelu_tanh(v1[1]), act_gelu_tanh(v1[2]), act_gelu_tanh(v1[3])}; }
                    u32x4 w; w.x = cvt_pk_bf16(v0[0], v0[1]); w.y = cvt_pk_bf16(v0[2], v0[3]); w.z = cvt_pk_bf16(v1[0], v1[1]); w.w = cvt_pk_bf16(v1[2], v1[3]);
                    if (!nostore) st16(rowp + bj * HALF, w); } }
    }
};
struct EpiQKV {
    static constexpr bool PERM = true, AFTER_DRAIN = false;
    bf16_t* QH; const float* ssq; const float* gq; const float* gk; PG8_LAS float* X; int mode;
    __device__ __forceinline__ void operator()(const f32x4 (&acc)[2][2][4][2], const Unit& u, int wr, int wc, int fr, int fq) const {
        const int sec = (mode & 1) ? 2 : (u.pn >> 3); const int row0 = u.pm * BM + wr * 64 + fr;
        if (sec < 2) {
#pragma unroll
            for (int ai = 0; ai < 2; ++ai)
#pragma unroll
                for (int m = 0; m < 4; ++m)
#pragma unroll
                    for (int bj = 0; bj < 2; ++bj) { const f32x4 a0 = acc[ai][bj][m][0], a1 = acc[ai][bj][m][1];
                        float s = ((a0[0] * a0[0] + a0[1] * a0[1]) + (a0[2] * a0[2] + a0[3] * a0[3])) + ((a1[0] * a1[0] + a1[1] * a1[1]) + (a1[2] * a1[2] + a1[3] * a1[3]));
                        s += __shfl_xor(s, 16); s += __shfl_xor(s, 32);
                        if (fq == 0) X[((ai * HALF + wr * 64 + m * 16 + fr) * 2 + bj) * 4 + wc] = s; }
            asm volatile("s_waitcnt lgkmcnt(0)\n\ts_barrier" ::: "memory");
        }
        int dcol = wc * 32 + 8 * fq; asm volatile("" : "+v"(dcol));
        f32x4 g0 = {1.f, 1.f, 1.f, 1.f}, g1 = {1.f, 1.f, 1.f, 1.f};
        if (sec == 0) { const int d = dcol; const f32x4 q0 = *(const f32x4*)(gq + d), q1 = *(const f32x4*)(gq + d + 4), k0 = *(const f32x4*)(gk + d), k1 = *(const f32x4*)(gk + d + 4);
            g0 = q0 * k0 * (0.08838834764831845f * 1.4426950408889634f); g1 = q1 * k1 * (0.08838834764831845f * 1.4426950408889634f); }
        bf16_t* sbase = QH + (size_t)sec * ((size_t)32 * 8192 * 128) + dcol;
#pragma unroll
        for (int ai = 0; ai < 2; ++ai)
#pragma unroll
            for (int m = 0; m < 4; ++m) { const int row = row0 + ai * HALF + m * 16; const int b = row >> 13, s = row & 8191; const float rs = rstd_row(ssq, row);
#pragma unroll
                for (int bj = 0; bj < 2; ++bj) { const int head = (u.pn & 7) * 2 + bj; float fac = rs;
                    if (sec < 2) { const f32x4 p = *(const PG8_LAS f32x4*)(X + ((ai * HALF + wr * 64 + m * 16 + fr) * 2 + bj) * 4);
                        fac = rs * __builtin_amdgcn_rsqf(((p[0] + p[1]) + (p[2] + p[3])) * (rs * rs) * (1.0f / 128.0f) + 1e-6f); }
                    const f32x4 v0 = acc[ai][bj][m][0] * fac * g0, v1 = acc[ai][bj][m][1] * fac * g1;
                    u32x4 w; w.x = cvt_pk_bf16(v0[0], v0[1]); w.y = cvt_pk_bf16(v0[2], v0[3]); w.z = cvt_pk_bf16(v1[0], v1[1]); w.w = cvt_pk_bf16(v1[2], v1[3]);
                    if (!(mode & 2)) st16(sbase + ((size_t)(b * 16 + head) * 8192 + s) * 128, w); } }
    }
};
struct EpiResid {
    static constexpr bool PERM = true, AFTER_DRAIN = false;
    const float* xin32; float* out32; bf16_t* xb; float* part; PG8_LAS float* X; const float* scale_part;
    __device__ __forceinline__ void operator()(const f32x4 (&acc)[2][2][4][2], const Unit& u, int wr, int wc, int fr, int fq) const {
        const int row0 = u.pm * BM + wr * 64 + fr; const int col0 = u.pn * BM + wc * 32 + 8 * fq;
#pragma unroll
        for (int ai = 0; ai < 2; ++ai)
#pragma unroll
            for (int m = 0; m < 4; ++m) { const int row = row0 + ai * HALF + m * 16; const size_t off = (size_t)row * 2048 + col0; float s = 0.f; float sc2 = 1.f;
                if (scale_part) { const float r_ = rstd_row(scale_part, row); sc2 = r_ * r_; }
#pragma unroll
                for (int bj = 0; bj < 2; ++bj) { f32x4 x0, x1;
                    if (xin32) { x0 = *(const f32x4*)(xin32 + off + bj * HALF); x1 = *(const f32x4*)(xin32 + off + bj * HALF + 4); }
                    else { const u32x4 w = *(const u32x4*)(xb + off + bj * HALF);
                        x0 = (f32x4){__uint_as_float(w.x << 16), __uint_as_float(w.x & 0xffff0000u), __uint_as_float(w.y << 16), __uint_as_float(w.y & 0xffff0000u)};
                        x1 = (f32x4){__uint_as_float(w.z << 16), __uint_as_float(w.z & 0xffff0000u), __uint_as_float(w.w << 16), __uint_as_float(w.w & 0xffff0000u)}; }
                    const f32x4 v0 = x0 + acc[ai][bj][m][0] * sc2, v1 = x1 + acc[ai][bj][m][1] * sc2;
                    if (out32) { *(f32x4*)(out32 + off + bj * HALF) = v0; *(f32x4*)(out32 + off + bj * HALF + 4) = v1; }
                    s += ((v0[0] * v0[0] + v0[1] * v0[1]) + (v0[2] * v0[2] + v0[3] * v0[3])) + ((v1[0] * v1[0] + v1[1] * v1[1]) + (v1[2] * v1[2] + v1[3] * v1[3]));
                    u32x4 w; w.x = cvt_pk_bf16(v0[0], v0[1]); w.y = cvt_pk_bf16(v0[2], v0[3]); w.z = cvt_pk_bf16(v1[0], v1[1]); w.w = cvt_pk_bf16(v1[2], v1[3]);
                    if (!out32) st16(xb + off + bj * HALF, w); }
                if (!out32) { s += __shfl_xor(s, 16); s += __shfl_xor(s, 32);
                if (fq == 0) X[(ai * HALF + wr * 64 + m * 16 + fr) * 4 + wc] = s; }
                asm volatile("" ::: "memory"); }
        if (out32) return;
        asm volatile("s_waitcnt lgkmcnt(0)\n\ts_barrier" ::: "memory");
        { int t = threadIdx.x; asm volatile("" : "+v"(t)); if (t < BM) { const f32x4 v = *(const PG8_LAS f32x4*)(X + t * 4); part[(size_t)(u.pm * BM + t) * 8 + u.pn] = (v[0] + v[1]) + (v[2] + v[3]); } }
    }
};
template <class Epi, class Sched, bool ALIGN_EPI = false, bool SP2 = false>
__device__ __forceinline__ void gemm_phase(PG8_LAS unsigned char* lds, const Gemm g, const Sched& S, const Epi& E) {
    int tid_raw = threadIdx.x; asm volatile("" : "+v"(tid_raw));
    const int tid = tid_raw, wid = __builtin_amdgcn_readfirstlane(tid >> 6), lane = tid & 63, wr = wid >> 2, wc = wid & 3, fr = lane & 15, fq = lane >> 4;
    const int K = g.K, nt = K / BK;
    unsigned voffA[2], voffB[2];
#pragma unroll
    for (int i = 0; i < 2; ++i) { int R, C; stage_rc(tid * 16 + i * 8192, R, C); const int Rb = Epi::PERM ? ((R & ~31) + perm32(R & 31)) : R;
        voffA[i] = (unsigned)(R * K + C) * 2u; voffB[i] = (unsigned)(Rb * K + C) * 2u; }
    const size_t kstep = (size_t)(BK * 2);
    const size_t hstep = (size_t)HALF * K * 2;
    const size_t tstep = 2 * hstep;
    const unsigned ldsw = (unsigned)wid * 1024u;
    const int aoff = lds_byte(wr * 64 + fr, fq * 8), boff = lds_byte(wc * 32 + fr, fq * 8);
#define PG8_SA(b, h) (((b) * 2 + (h)) * HTB)
#define PG8_SB(b, h) ((4 + (b) * 2 + (h)) * HTB)
#ifndef PG8_AUX_voffA
#define PG8_AUX_voffA 0
#endif
#ifndef PG8_AUX_voffB
#define PG8_AUX_voffB 0
#endif
#define PG8_STAGE(bufoff, gbase, voff) do { _Pragma("unroll") for (int _i = 0; _i < 2; ++_i) \
        __builtin_amdgcn_global_load_lds((const unsigned*)((const char*)(gbase) + (voff)[_i]), (PG8_LAS unsigned*)(lds + (bufoff) + ldsw + _i * 8192), 16, 0, PG8_AUX_##voff); } while (0)
#define PG8_LDA(dst, b, h) do { _Pragma("unroll") for (int m = 0; m < 4; ++m) _Pragma("unroll") for (int k = 0; k < 2; ++k) dst[m][k] = *(const PG8_LAS bf16x8*)(lds + PG8_SA(b, h) + aoff + m * 2048 + k * 1024); } while (0)
#define PG8_LDB(dst, b, h) do { _Pragma("unroll") for (int n = 0; n < 2; ++n) _Pragma("unroll") for (int k = 0; k < 2; ++k) dst[n][k] = *(const PG8_LAS bf16x8*)(lds + PG8_SB(b, h) + boff + n * 2048 + k * 1024); } while (0)
#define PG8_MMA(ai, bj, At, Bt) do { __builtin_amdgcn_s_setprio(1); _Pragma("unroll") for (int m = 0; m < 4; ++m) _Pragma("unroll") for (int n = 0; n < 2; ++n) _Pragma("unroll") for (int k = 0; k < 2; ++k) \
        acc[ai][bj][m][n] = __builtin_amdgcn_mfma_f32_16x16x32_bf16(Bt[n][k], At[m][k], acc[ai][bj][m][n], 0, 0, 0); __builtin_amdgcn_s_setprio(0); } while (0)
#define PG8_WAIT_V(n) asm volatile("s_waitcnt vmcnt(" #n ")" ::: "memory")
#define PG8_WAIT_L(n) asm volatile("s_waitcnt lgkmcnt(" #n ")" ::: "memory")
#define PG8_BAR __builtin_amdgcn_s_barrier()
#define PG8_SCHED __builtin_amdgcn_sched_barrier(0)
    Unit cur, nxt; int ui = 0;
    if (!S.next(0, cur)) return;
    f32x4 acc[2][2][4][2];
#pragma unroll
    for (int a = 0; a < 2; ++a)
#pragma unroll
        for (int b = 0; b < 2; ++b)
#pragma unroll
            for (int m = 0; m < 4; ++m)
#pragma unroll
                for (int n = 0; n < 2; ++n) acc[a][b][m][n] = (f32x4){0.f, 0.f, 0.f, 0.f};
    bf16x8 At[4][2], B0[2][2], B1[2][2];
    const char* cA = (const char*)g.A + (size_t)cur.pm * tstep; const char* cB = (const char*)g.Bt + (size_t)cur.pn * tstep;
    S.a_ready(cur);
    if constexpr (SP2) {
        PG8_STAGE(PG8_SB(0, 0), cB, voffB); PG8_STAGE(PG8_SB(0, 1), cB + hstep, voffB); PG8_STAGE(PG8_SA(0, 0), cA, voffA); PG8_STAGE(PG8_SA(0, 1), cA + hstep, voffA);
        if (wr == 1) PG8_BAR;
        PG8_WAIT_V(2); PG8_BAR;
        PG8_STAGE(PG8_SB(1, 0), cB + kstep, voffB); PG8_STAGE(PG8_SA(1, 0), cA + kstep, voffA); PG8_STAGE(PG8_SB(1, 1), cB + hstep + kstep, voffB);
        PG8_WAIT_V(6); PG8_BAR;
    } else {
        PG8_STAGE(PG8_SB(0, 0), cB, voffB); PG8_STAGE(PG8_SA(0, 0), cA, voffA); PG8_STAGE(PG8_SB(0, 1), cB + hstep, voffB); PG8_STAGE(PG8_SA(0, 1), cA + hstep, voffA);
        if (wr == 1) PG8_BAR;
        PG8_WAIT_V(4); PG8_BAR;
        PG8_STAGE(PG8_SB(1, 0), cB + kstep, voffB); PG8_STAGE(PG8_SA(1, 0), cA + kstep, voffA); PG8_STAGE(PG8_SB(1, 1), cB + hstep + kstep, voffB);
        PG8_WAIT_V(6); PG8_BAR;
    }
    for (;;) {
        const bool has_next = S.next(ui + 1, nxt);
        const char* nA = has_next ? (const char*)g.A + (size_t)nxt.pm * tstep : cA; const char* nB = has_next ? (const char*)g.Bt + (size_t)nxt.pn * tstep : cB;
        for (int t = 0; t < nt; t += 2) {
            const bool last = (t == nt - 2);
            const char* a1 = cA + (size_t)(t + 1) * kstep;
            const char* a2 = last ? nA : cA + (size_t)(t + 2) * kstep; const char* b2 = last ? nB : cB + (size_t)(t + 2) * kstep;
            const char* a3 = a2 + kstep; const char* b3 = b2 + kstep;
            if (last && has_next) S.a_ready(nxt);
            if constexpr (SP2) {
            PG8_LDB(B0, 0, 0); PG8_LDB(B1, 0, 1); PG8_SCHED; PG8_LDA(At, 0, 0); PG8_STAGE(PG8_SA(1, 1), a1 + hstep, voffA);
            PG8_WAIT_V(8); PG8_WAIT_L(0); PG8_BAR; PG8_MMA(0, 0, At, B0); PG8_MMA(0, 1, At, B1); PG8_BAR; PG8_SCHED;
            PG8_LDA(At, 0, 1); PG8_STAGE(PG8_SB(0, 0), b2, voffB); PG8_STAGE(PG8_SB(0, 1), b2 + hstep, voffB); PG8_STAGE(PG8_SA(0, 0), a2, voffA);
            PG8_WAIT_V(8); PG8_WAIT_L(0); PG8_BAR; PG8_MMA(1, 0, At, B0); PG8_MMA(1, 1, At, B1); PG8_BAR; PG8_SCHED;
            PG8_LDB(B0, 1, 0); PG8_LDB(B1, 1, 1); PG8_SCHED; PG8_LDA(At, 1, 0); PG8_STAGE(PG8_SA(0, 1), a2 + hstep, voffA);
            PG8_WAIT_V(8); PG8_WAIT_L(0); PG8_BAR; PG8_MMA(0, 0, At, B0); PG8_MMA(0, 1, At, B1); PG8_BAR; PG8_SCHED;
            PG8_LDA(At, 1, 1); PG8_STAGE(PG8_SB(1, 0), b3, voffB); PG8_STAGE(PG8_SB(1, 1), b3 + hstep, voffB); PG8_STAGE(PG8_SA(1, 0), a3, voffA);
            PG8_WAIT_V(8); PG8_WAIT_L(0); PG8_BAR; PG8_MMA(1, 0, At, B0); PG8_MMA(1, 1, At, B1); PG8_BAR; PG8_SCHED;
            } else {
            PG8_LDB(B0, 0, 0); PG8_SCHED; PG8_LDA(At, 0, 0); PG8_STAGE(PG8_SA(1, 1), a1 + hstep, voffA);
            PG8_WAIT_L(8); PG8_BAR; PG8_WAIT_L(0); PG8_MMA(0, 0, At, B0); PG8_BAR; PG8_SCHED;
            PG8_LDB(B1, 0, 1); PG8_STAGE(PG8_SB(0, 0), b2, voffB);
            PG8_BAR; PG8_WAIT_L(0); PG8_MMA(0, 1, At, B1); PG8_BAR;
            PG8_LDA(At, 0, 1); PG8_STAGE(PG8_SA(0, 0), a2, voffA);
            PG8_BAR; PG8_WAIT_L(0); PG8_MMA(1, 0, At, B0); PG8_BAR; PG8_SCHED;
            PG8_STAGE(PG8_SB(0, 1), b2 + hstep, voffB);
            PG8_WAIT_V(6); PG8_BAR; PG8_MMA(1, 1, At, B1); PG8_BAR;
            PG8_LDB(B0, 1, 0); PG8_SCHED; PG8_LDA(At, 1, 0); PG8_STAGE(PG8_SA(0, 1), a2 + hstep, voffA);
            PG8_WAIT_L(8); PG8_BAR; PG8_WAIT_L(0); PG8_MMA(0, 0, At, B0); PG8_BAR; PG8_SCHED;
            PG8_LDB(B1, 1, 1); PG8_STAGE(PG8_SB(1, 0), b3, voffB);
            PG8_BAR; PG8_WAIT_L(0); PG8_MMA(0, 1, At, B1); PG8_BAR;
            PG8_LDA(At, 1, 1); PG8_STAGE(PG8_SA(1, 0), a3, voffA);
            PG8_BAR; PG8_WAIT_L(0); PG8_MMA(1, 0, At, B0); PG8_BAR; PG8_SCHED;
            PG8_STAGE(PG8_SB(1, 1), b3 + hstep, voffB);
            PG8_WAIT_V(6); PG8_BAR; PG8_MMA(1, 1, At, B1); PG8_BAR;
            }
        }
        if constexpr (ALIGN_EPI) { if (wr == 0) PG8_BAR; }
        if constexpr (!Epi::AFTER_DRAIN) { E(acc, cur, wr, wc, fr, fq); S.done(cur); }
        if (!has_next) break;
#pragma unroll
        for (int a = 0; a < 2; ++a)
#pragma unroll
            for (int b = 0; b < 2; ++b)
#pragma unroll
                for (int m = 0; m < 4; ++m)
#pragma unroll
                    for (int n = 0; n < 2; ++n) acc[a][b][m][n] = (f32x4){0.f, 0.f, 0.f, 0.f};
        cur = nxt; cA = nA; cB = nB; ++ui;
        if constexpr (ALIGN_EPI) { if (wr == 1) PG8_BAR; }
    }
    PG8_WAIT_V(0);
    if constexpr (!ALIGN_EPI) { if (wr == 0) PG8_BAR; }
    PG8_BAR;
    if constexpr (Epi::AFTER_DRAIN) { E.fused(acc, cur, wr, wc, fr, fq, lds, wid, lane); S.done(cur); }
#undef PG8_SA
#undef PG8_SB
#undef PG8_STAGE
#undef PG8_LDA
#undef PG8_LDB
#undef PG8_MMA
#undef PG8_WAIT_V
#undef PG8_WAIT_L
#undef PG8_BAR
#undef PG8_SCHED
}
}
namespace att {
typedef unsigned short bf16;
typedef short bf16x8 __attribute__((ext_vector_type(8)));
typedef short s16x4 __attribute__((ext_vector_type(4)));
typedef float f32x16 __attribute__((ext_vector_type(16)));
typedef float f32x4 __attribute__((ext_vector_type(4)));
typedef unsigned u32x4 __attribute__((ext_vector_type(4)));
constexpr int D = 128, PQ = 128, PO = 2048, SEQ = 8192;
constexpr size_t SECB = (size_t)32 * 8192 * 128 * 2;
constexpr float THR = 8.f, LOG2E = 1.4426950408889634f;
constexpr int NW = 8, QBLK = 32, KVBLK = 64, QB = NW * QBLK;
constexpr int SHM_V = KVBLK * D * 2, SHM_K = KVBLK * D * 2;
constexpr int OFF_WS = 2 * SHM_V + 2 * SHM_K, OFF_CB = OFF_WS + NW * 64 * 4, LDS_BYTES = OFF_CB + SEQ * 4;
#define KSWZ(row, colB) ((row) * 256 + ((colB) ^ (((row) & 7) << 4)))
#define SBAR() __builtin_amdgcn_sched_barrier(0)
__device__ __forceinline__ int v_st(int k, int c) { const int kk = (k & ~0xC) | ((k & 4) << 1) | ((k & 8) >> 1); return ((kk >> 3) * 4 + (c >> 5)) * 512 + ((kk & 7) * 32 + (c & 31)) * 2; }
__device__ __forceinline__ int v_rd_base(int lane) { return ((lane & 3) << 3) | (((lane >> 2) & 3) << 6) | (((lane >> 4) & 1) << 5) | (((lane >> 5) & 1) << 8); }
constexpr int v_rd_off(int d0, int ks, int half) { return d0 * 512 + ks * 4096 + half * 2048; }
__device__ __forceinline__ int crow(int r, int hi) { return (r & 3) + 8 * (r >> 2) + 4 * hi; }
__device__ __forceinline__ unsigned cvtpk(float lo, float hi) { unsigned r; asm volatile("v_cvt_pk_bf16_f32 %0, %1, %2" : "=v"(r) : "v"(lo), "v"(hi)); return r; }
__device__ __forceinline__ bf16x8 ld8(const bf16* p) { return *reinterpret_cast<const bf16x8*>(p); }
__device__ __forceinline__ void mask_tile(f32x16& p0, f32x16& p1, int dq) {
    const float NEG = -__builtin_inff();
#pragma unroll
    for (int r = 0; r < 16; ++r) { const int c = (r & 3) + 8 * (r >> 2); if (dq - c < 0) p0[r] = NEG; if (dq - c - 32 < 0) p1[r] = NEG; }
}
__device__ __forceinline__ void partialSM(f32x16& p0, f32x16& p1, float& m_reg, float& mn, float& alpha) {
    float pmax = p0[0];
#pragma unroll
    for (int r = 1; r < 16; ++r) pmax = fmaxf(pmax, p0[r]);
#pragma unroll
    for (int r = 0; r < 16; ++r) pmax = fmaxf(pmax, p1[r]);
    { auto rr = __builtin_amdgcn_permlane32_swap(__float_as_uint(pmax), __float_as_uint(pmax), false, false); pmax = fmaxf(__uint_as_float(rr[0]), __uint_as_float(rr[1])); }
    if (__builtin_expect(__all((pmax - m_reg) <= THR), 1)) { mn = m_reg; alpha = 1.f; }
    else { mn = fmaxf(m_reg, pmax); alpha = __builtin_amdgcn_exp2f(m_reg - mn); m_reg = mn; }
#pragma unroll
    for (int r = 0; r < 16; ++r) { p0[r] -= mn; p1[r] -= mn; }
#pragma unroll
    for (int r = 0; r < 16; ++r) p0[r] = __builtin_amdgcn_exp2f(p0[r]);
}
__device__ __forceinline__ void finishSM(f32x16& p0, f32x16& p1, float alpha, float& l_reg, bf16x8& pa0, bf16x8& pa1, bf16x8& pa2, bf16x8& pa3) {
#pragma unroll
    for (int r = 0; r < 16; ++r) p1[r] = __builtin_amdgcn_exp2f(p1[r]);
    float ps = 0;
#pragma unroll
    for (int r = 0; r < 16; ++r) ps += p0[r];
#pragma unroll
    for (int r = 0; r < 16; ++r) ps += p1[r];
    { auto rr = __builtin_amdgcn_permlane32_swap(__float_as_uint(ps), __float_as_uint(ps), false, false); ps = __uint_as_float(rr[0]) + __uint_as_float(rr[1]); }
    l_reg = l_reg * alpha + ps;
#define PK4(P, B_, OUT) do { unsigned a0 = cvtpk(P[B_+0], P[B_+1]), a1 = cvtpk(P[B_+2], P[B_+3]);                          \
        unsigned b0 = cvtpk(P[B_+4], P[B_+5]), b1 = cvtpk(P[B_+6], P[B_+7]);                                             \
        auto r0 = __builtin_amdgcn_permlane32_swap(a0, b0, false, false); auto r1 = __builtin_amdgcn_permlane32_swap(a1, b1, false, false); \
        u32x4 w = {r0[0], r1[0], r0[1], r1[1]}; OUT = *reinterpret_cast<bf16x8*>(&w); } while (0)
    PK4(p0, 0, pa0); PK4(p0, 8, pa1); PK4(p1, 0, pa2); PK4(p1, 8, pa3);
#undef PK4
}
__device__ __forceinline__ void bias_init(f32x16& p0, f32x16& p1, const float* cb_t, int hi) {
    const float* cb = cb_t + 4 * hi;
    const f32x4 a0 = *(const f32x4*)(cb), a1 = *(const f32x4*)(cb + 8), a2 = *(const f32x4*)(cb + 16), a3 = *(const f32x4*)(cb + 24);
    const f32x4 b0 = *(const f32x4*)(cb + 32), b1 = *(const f32x4*)(cb + 40), b2 = *(const f32x4*)(cb + 48), b3 = *(const f32x4*)(cb + 56);
    p0 = (f32x16){a0[0], a0[1], a0[2], a0[3], a1[0], a1[1], a1[2], a1[3], a2[0], a2[1], a2[2], a2[3], a3[0], a3[1], a3[2], a3[3]};
    p1 = (f32x16){b0[0], b0[1], b0[2], b0[3], b1[0], b1[1], b1[2], b1[3], b2[0], b2[1], b2[2], b2[3], b3[0], b3[1], b3[2], b3[3]};
}
template <int KB>
__device__ __forceinline__ void qkt(f32x16& p0, f32x16& p1, const char* K_lds, int r32, int hi, const bf16x8* qr) {
    const char* kb[4];
#pragma unroll
    for (int dd = 0; dd < 4; ++dd) kb[dd] = K_lds + KB * SHM_K + KSWZ(r32, (dd * 16 + hi * 8) * 2);
#pragma unroll
    for (int d0 = 0; d0 < 8; ++d0) { const char* a = kb[d0 & 3] + (d0 >> 2) * 128;
        bf16x8 b0 = *reinterpret_cast<const bf16x8*>(a);
        bf16x8 b1 = *reinterpret_cast<const bf16x8*>(a + 32 * 256);
        p0 = __builtin_amdgcn_mfma_f32_32x32x16_bf16(b0, qr[d0], p0, 0, 0, 0);
        p1 = __builtin_amdgcn_mfma_f32_32x32x16_bf16(b1, qr[d0], p1, 0, 0, 0); }
}
template <int VB>
__device__ __forceinline__ void pv_tile(f32x16* o, int vb0, bf16x8 pa0, bf16x8 pa1, bf16x8 pa2, bf16x8 pa3) {
#define TRRD(dst, off) asm volatile("ds_read_b64_tr_b16 %0, %1 offset:%2" : "=&v"(dst) : "v"(vb0), "i"(off) : "memory")
#define PV_D0(d0) do { s16x4 l0, l1, l2, l3, h0, h1, h2, h3; constexpr int b_ = VB * SHM_V + v_rd_off(d0, 0, 0); \
        TRRD(l0, b_); TRRD(h0, b_ + 2048); TRRD(l1, b_ + 4096); TRRD(h1, b_ + 6144); TRRD(l2, b_ + 8192); TRRD(h2, b_ + 10240); TRRD(l3, b_ + 12288); TRRD(h3, b_ + 14336); \
        asm volatile("s_waitcnt lgkmcnt(0)" ::: "memory"); SBAR();   \
        o[d0] = __builtin_amdgcn_mfma_f32_32x32x16_bf16(pa0, (bf16x8){l0[0], l0[1], l0[2], l0[3], h0[0], h0[1], h0[2], h0[3]}, o[d0], 0, 0, 0);   \
        o[d0] = __builtin_amdgcn_mfma_f32_32x32x16_bf16(pa1, (bf16x8){l1[0], l1[1], l1[2], l1[3], h1[0], h1[1], h1[2], h1[3]}, o[d0], 0, 0, 0);   \
        o[d0] = __builtin_amdgcn_mfma_f32_32x32x16_bf16(pa2, (bf16x8){l2[0], l2[1], l2[2], l2[3], h2[0], h2[1], h2[2], h2[3]}, o[d0], 0, 0, 0);   \
        o[d0] = __builtin_amdgcn_mfma_f32_32x32x16_bf16(pa3, (bf16x8){l3[0], l3[1], l3[2], l3[3], h3[0], h3[1], h3[2], h3[3]}, o[d0], 0, 0, 0); } while (0)
    PV_D0(0); PV_D0(1); PV_D0(2); PV_D0(3);
#undef PV_D0
#undef TRRD
}
struct BlockRef { unsigned qoff, koff, ooff; int P0; int bh; };
struct Seam { bf16x8 qr[8]; bf16x8 st_v0, st_v1, st_k0, st_k1; };
#define GAS1 __attribute__((address_space(1)))
#define LDO(base, boff) (*(const GAS1 bf16x8*)((const GAS1 char*)(base) + (boff)))
#define VMW() asm volatile("s_waitcnt vmcnt(0)" ::: "memory")
#define VMWN(n) asm volatile("s_waitcnt vmcnt(%0)" :: "i"(n) : "memory")
#define OPQ(p) asm volatile("" : "+s"(p))
#define SLOAD_H(Kp, k0) do { const char* kt_ = (Kp) + (size_t)(k0) * (PQ * 2); OPQ(kt_); const char* vt_ = kt_ + SECB; OPQ(vt_); unsigned o0_ = so0, o1_ = so1; asm volatile("" : "+v"(o0_), "+v"(o1_));            \
                         S.st_v0 = LDO(vt_, o0_); S.st_v1 = LDO(vt_, o1_); S.st_k0 = LDO(kt_, o0_); S.st_k1 = LDO(kt_, o1_); } while (0)
#define SWRITE_HK(bf) do { *(bf16x8*)(K_lds + (bf) * SHM_K + kws) = S.st_k0; *(bf16x8*)(K_lds + (bf) * SHM_K + kws + 32 * 256) = S.st_k1; } while (0)
#define SWRITE_HV(bf) do { *(bf16x8*)(V_lds + (bf) * SHM_V + vst0) = S.st_v0; *(bf16x8*)(V_lds + (bf) * SHM_V + vst1) = S.st_v1; } while (0)
#define SWRITE_H(bf) do { SWRITE_HV(bf); SWRITE_HK(bf); } while (0)
__device__ __forceinline__ void prime(const BlockRef& cur, const char* QKVb, char* lds, Seam& S) {
    int tid_raw = threadIdx.x; asm volatile("" : "+v"(tid_raw));
    const int tid = tid_raw, wid = __builtin_amdgcn_readfirstlane(tid >> 6), lane = tid & 63, r32 = lane & 31, hi = lane >> 5;
    const int sr = tid >> 4, sc = (tid & 15) * 8, kws = KSWZ(sr, sc * 2); char* K_lds = lds + 2 * SHM_V;
    const unsigned so0 = (unsigned)(sr * PQ + sc) * 2u, so1 = so0 + 32u * PQ * 2u, qo = (unsigned)(r32 * PQ + hi * 8) * 2u;
    { const char* qb_ = QKVb + cur.qoff + (size_t)(wid * QBLK) * PQ * 2; OPQ(qb_); unsigned qo_ = qo; asm volatile("" : "+v"(qo_));
#pragma unroll
    for (int d0 = 0; d0 < 8; ++d0) S.qr[d0] = LDO(qb_, qo_ + d0 * 32); }
    { const char* Kh = QKVb + cur.koff; SLOAD_H(Kh, 0); } VMW(); SWRITE_HK(0);
    __syncthreads();
}
__device__ __forceinline__ void block(const BlockRef& cur, const BlockRef& nxt, const char* QKVb, char* OBb, char* lds, Seam& S) {
    int tid_raw = threadIdx.x; asm volatile("" : "+v"(tid_raw));
    const int tid = tid_raw, wid = __builtin_amdgcn_readfirstlane(tid >> 6), lane = tid & 63, r32 = lane & 31, hi = lane >> 5;
    const int NT = (cur.P0 + QB) / KVBLK;
    const int qlo = cur.P0 + wid * QBLK, qm = qlo + r32 - 4 * hi;
    char* V_lds = lds; char* K_lds = lds + 2 * SHM_V;
    float* ws = (float*)(lds + OFF_WS) + wid * 64; float* li_l = ws, * al_l = ws + 32; const float* cb_l = (const float*)(lds + OFF_CB);
    float m_reg = -1e30f, l_reg = 0; f32x16 o[4] = {};
    const int sr = tid >> 4, sc = (tid & 15) * 8, vst0 = v_st(sr, sc), vst1 = v_st(32 + sr, sc), kws = KSWZ(sr, sc * 2);
    const unsigned so0 = (unsigned)(sr * PQ + sc) * 2u, so1 = so0 + 32u * PQ * 2u, qo = (unsigned)(r32 * PQ + hi * 8) * 2u;
    const int vb0 = (int)(uintptr_t)V_lds + v_rd_base(lane);
    const char* Kh = QKVb + cur.koff;
#define RESC(a) do { if (__any((a) < 1.f)) { if (hi == 0) al_l[r32] = (a); asm volatile("s_waitcnt lgkmcnt(0)" ::: "memory");              \
                     for (int d_ = 0; d_ < 4; ++d_) for (int r = 0; r < 16; ++r) o[d_][r] *= al_l[crow(r, hi)]; } } while (0)
#define KBASE(t) ((t) * KVBLK)
#define MASKT(P0_, P1_, t) do { const int kb_ = KBASE(t); if (kb_ + KVBLK - 1 > qlo) mask_tile(P0_, P1_, qm - kb_); } while (0)
#define SEAM_K0() do { VMWN(8); SWRITE_HK(0); SBAR(); } while (0)
    f32x16 pA0, pA1, pB0, pB1; float mnA, mnB, alA, alB; bf16x8 pa0, pa1, pa2, pa3;
    SWRITE_HV(0); SBAR();
    if (NT > 1) { SLOAD_H(Kh, KBASE(1)); }
    bias_init(pA0, pA1, cb_l, hi);
    SBAR(); qkt<0>(pA0, pA1, K_lds, r32, hi, S.qr);
    if (NT > 1) bias_init(pB0, pB1, cb_l + KBASE(1), hi);
    MASKT(pA0, pA1, 0); partialSM(pA0, pA1, m_reg, mnA, alA);
    if (NT > 1) { VMW(); SWRITE_H(1); }
    __syncthreads();
#define HALF_STEP(PX0, PX1, mnX, alX, PY0, PY1, alY, t, KB, VB, SB) do {                                                      \
        SBAR(); if ((t) + 1 < NT) { SLOAD_H(Kh, KBASE((t) + 1)); SBAR(); }         \
        qkt<KB>(PX0, PX1, K_lds, r32, hi, S.qr);                                                                              \
        finishSM(PY0, PY1, alY, l_reg, pa0, pa1, pa2, pa3); SBAR();                                                           \
        if ((t) + 1 < NT) bias_init(PY0, PY1, cb_l + KBASE((t) + 1), hi);     \
        pv_tile<VB>(o, vb0, pa0, pa1, pa2, pa3); MASKT(PX0, PX1, (t)); partialSM(PX0, PX1, m_reg, mnX, alX);                  \
        __syncthreads();                                                                                                      \
        if ((t) + 1 < NT) { VMW(); SWRITE_H(SB); }                                                                      \
        RESC(alX); __syncthreads(); } while (0)
    for (int t = 1; t + 1 < NT; t += 2) {
        HALF_STEP(pB0, pB1, mnB, alB, pA0, pA1, alA, t, 1, 0, 0);
        HALF_STEP(pA0, pA1, mnA, alA, pB0, pB1, alB, t + 1, 0, 1, 1);
    }
    const bool even = (NT & 1) == 0;
    if (even) { SBAR(); qkt<1>(pB0, pB1, K_lds, r32, hi, S.qr); SBAR(); }
    { const char* Kn = QKVb + nxt.koff; SLOAD_H(Kn, 0); } SBAR();
    { const char* qb_ = QKVb + nxt.qoff + (size_t)(wid * QBLK) * PQ * 2; OPQ(qb_); unsigned qo_ = qo; asm volatile("" : "+v"(qo_));
#pragma unroll
    for (int d0 = 0; d0 < 8; ++d0) S.qr[d0] = LDO(qb_, qo_ + d0 * 32); }
    SBAR();
    finishSM(pA0, pA1, alA, l_reg, pa0, pa1, pa2, pa3); SBAR();
    pv_tile<0>(o, vb0, pa0, pa1, pa2, pa3);
    if (even) { MASKT(pB0, pB1, NT - 1); partialSM(pB0, pB1, m_reg, mnB, alB); __syncthreads(); RESC(alB);
        finishSM(pB0, pB1, alB, l_reg, pa0, pa1, pa2, pa3); SBAR(); pv_tile<1>(o, vb0, pa0, pa1, pa2, pa3); }
    SBAR(); SEAM_K0();
    if (hi == 0) li_l[r32] = l_reg; asm volatile("s_waitcnt lgkmcnt(0)" ::: "memory");
    float rli[16];
#pragma unroll
    for (int r = 0; r < 16; ++r) rli[r] = __builtin_amdgcn_rcpf(li_l[crow(r, hi)]);
    char* Ow = OBb + cur.ooff + (size_t)(wid * QBLK) * PO * 2; OPQ(Ow); unsigned oo = (unsigned)(4 * hi * PO + r32) * 2u; asm volatile("" : "+v"(oo));
#pragma unroll
    for (int r = 0; r < 16; ++r) { const unsigned orb = (unsigned)(((r & 3) + 8 * (r >> 2)) * PO) * 2u;
#pragma unroll
        for (int d0 = 0; d0 < 4; ++d0) { const float v = o[d0][r] * rli[r]; const float vn = __uint_as_float(__builtin_amdgcn_mov_dpp(__float_as_uint(v), 0xB1, 0xf, 0xf, true));
            if ((r32 & 1) == 0) *(GAS1 unsigned*)((GAS1 char*)Ow + (oo + orb + d0 * 64)) = cvtpk(v, vn); } }
    __syncthreads();
#undef RESC
#undef KBASE
#undef MASKT
#undef SEAM_K0
#undef HALF_STEP
}
#undef LDO
#undef GAS1
#undef OPQ
#undef VMW
#undef VMWN
#undef SLOAD_H
#undef SWRITE_HK
#undef SWRITE_HV
#undef SWRITE_H
__device__ __forceinline__ BlockRef make_ref(int L, int pass) {
    const int xcd = L & 7, k = L >> 3, bh = (k >> 4) * 8 + xcd, x = k & 15, qb = pass ? 31 - x : x, b = bh >> 4, h = bh & 15;
    BlockRef r; r.P0 = qb * QB; r.bh = bh;
    r.qoff = (unsigned)(((bh * SEQ + r.P0) * PQ) * 2); r.koff = (unsigned)(SECB + (size_t)(bh * SEQ) * PQ * 2); r.ooff = (unsigned)(((b * SEQ + r.P0) * PO + h * D) * 2);
    return r;
}
__device__ __forceinline__ void attn_phase(char* lds, const bf16* QKV, bf16* OB, const float* LP, const float* TT) {
    const int total = 512; int stride = gridDim.x, L = blockIdx.x; asm volatile("" : "+s"(stride), "+s"(L)); if (L >= total) return;
    int pass = 0; BlockRef cur = make_ref(L, 0); Seam S; int bh_lds = -1; const char* QKVb = (const char*)QKV; char* OBb = (char*)OB;
    prime(cur, QKVb, lds, S);
    for (;;) {
        if (cur.bh != bh_lds) {
            int t0_ = threadIdx.x; asm volatile("" : "+v"(t0_)); const int b_ = cur.bh >> 4, h_ = cur.bh & 15, ln_ = t0_ & 63, wv_ = t0_ >> 6;
            float* wt_ = (float*)(lds + OFF_WS); float* dst = (float*)(lds + OFF_CB);
            const float tt_ = TT[(size_t)(b_ * 512 + t0_) * 16 + h_]; float inc_ = tt_;
#pragma unroll
            for (int o_ = 1; o_ < 64; o_ <<= 1) { const float u_ = __shfl_up(inc_, o_); if (ln_ >= o_) inc_ += u_; }
            if (ln_ == 63) wt_[wv_] = inc_;
            __syncthreads();
            float off_ = inc_ - tt_; for (int w_ = 0; w_ < wv_; ++w_) off_ += wt_[w_];
            const float* lp_ = LP + ((size_t)b_ * SEQ + (size_t)t0_ * 16) * 16 + h_;
#pragma unroll
            for (int i = 0; i < 16; i += 4) { f32x4 v_ = {lp_[(i + 0) * 16], lp_[(i + 1) * 16], lp_[(i + 2) * 16], lp_[(i + 3) * 16]}; *(f32x4*)(dst + t0_ * 16 + i) = (v_ + off_) * (-LOG2E); }
            bh_lds = cur.bh; __syncthreads(); }
        const bool more_pass = pass == 0, more_item = L + stride < total, last = !more_pass && !more_item;
        int passn = pass + 1, Ln = L; if (!more_pass) { passn = 0; Ln = more_item ? L + stride : L; }
        const BlockRef nxt = last ? cur : make_ref(Ln, passn);
        block(cur, nxt, QKVb, OBb, lds, S);
        if (last) break;
        cur = nxt; pass = passn; L = Ln;
    }
}
#undef SBAR
#undef KSWZ
}
#define LAS __attribute__((address_space(3)))
typedef unsigned short bf16;
typedef unsigned v4u __attribute__((ext_vector_type(4)));
typedef unsigned v2u __attribute__((ext_vector_type(2)));
typedef float f32x4 __attribute__((ext_vector_type(4)));
typedef short bf16x8 __attribute__((ext_vector_type(8)));
constexpr int NWAVES = 8;
constexpr int M = 16384, DM = 2048, SEQ = 8192, NH = 16, HD = 128, FF = 8192, NQKV = 6144, NFOXW = 6160, NUV = 4096;
#ifndef NDEPTH
#define NDEPTH 4
#endif
constexpr int DEPTH = NDEPTH;
constexpr float EPS = 1e-6f;
constexpr size_t MiB = 1u << 20;
constexpr size_t WS_CTL = 0, WS_LF = 1 * MiB, WS_C = 2 * MiB, WS_XB = 4 * MiB, WS_FWIN = 68 * MiB, WS_FWOUT = 117 * MiB, WS_SWIN = 133 * MiB, WS_SWOUT = 165 * MiB,
                 WS_W1 = 181 * MiB, WS_W2 = 309 * MiB, WS_BIG = 437 * MiB, WS_SSQ = 693 * MiB, WS_END = 698 * MiB;
constexpr size_t FWIN_STRIDE = (size_t)NFOXW * DM;
constexpr int LDS_BYTES = 147456, LDS_X = 131072, LDS_MISC = 131072 + 8192;
static_assert(att::LDS_BYTES <= 131072 && pg8::STAGE_BYTES == 131072, "LDS map");

__device__ __forceinline__ unsigned pk2(float lo, float hi) { unsigned r; asm volatile("v_cvt_pk_bf16_f32 %0, %1, %2" : "=v"(r) : "v"(lo), "v"(hi)); return r; }
__device__ __forceinline__ float bf_lo(unsigned w) { return __uint_as_float(w << 16); }
__device__ __forceinline__ float bf_hi(unsigned w) { return __uint_as_float(w & 0xffff0000u); }
__device__ __forceinline__ float wave_sum(float v) {
#pragma unroll
    for (int o = 1; o < 64; o <<= 1) v += __shfl_xor(v, o);
    return v;
}
#define LDS_WAIT() asm volatile("s_waitcnt lgkmcnt(0)" ::: "memory")
__device__ __forceinline__ void p0_transpose_item(const float* W, int K, int N, const float* gain, bf16* WT, LAS float* scr, int item, int lane) {
    const int nblk = (N + 63) / 64, kb = item / nblk, nb = item % nblk, k0 = 64 * kb, n0 = 64 * nb;
    const int nl = lane & 15, kr = lane >> 4, nn = n0 + 4 * nl; const bool nok = nn < N;
    f32x4 v[16];
#pragma unroll
    for (int i = 0; i < 16; ++i) v[i] = nok ? *(const f32x4*)(W + (size_t)(k0 + 4 * i + kr) * N + nn) : (f32x4){0.f, 0.f, 0.f, 0.f};
#pragma unroll
    for (int i = 0; i < 16; ++i) { const int kk = 4 * i + kr; const float g = gain ? gain[k0 + kk] : 1.f; LAS float* d = scr + kk * 65 + 4 * nl;
        d[0] = v[i][0] * g; d[1] = v[i][1] * g; d[2] = v[i][2] * g; d[3] = v[i][3] * g; }
    LDS_WAIT(); asm volatile("" ::: "memory");
    const int c = lane & 7;
#pragma unroll
    for (int j = 0; j < 8; ++j) { const int n = (lane >> 3) + 8 * j; const LAS float* s = scr + (8 * c) * 65 + n;
        v4u o; o.x = pk2(s[0 * 65], s[1 * 65]); o.y = pk2(s[2 * 65], s[3 * 65]); o.z = pk2(s[4 * 65], s[5 * 65]); o.w = pk2(s[6 * 65], s[7 * 65]);
        if (n0 + n < N) *(v4u*)(WT + (size_t)(n0 + n) * K + k0 + 8 * c) = o; }
    LDS_WAIT(); asm volatile("" ::: "memory");
}
#define XB_TMO      128
#define XB_XCNT(j)  (256  + 64 * (j))
#define XB_XSUB(j)  (1280 + 64 * (j))
#define XB_XGEN(j)  (2304 + 64 * (j))
#define XB_TOP      3328
#define XB_TOPGEN   3392
#define XCD_BAR_WORDS 3456
#define XB_SPIN_CAP (1u << 18)

__device__ __forceinline__ unsigned xb_ld(unsigned* p)              { return __hip_atomic_load(p, __ATOMIC_RELAXED, __HIP_MEMORY_SCOPE_AGENT); }
__device__ __forceinline__ unsigned xb_add(unsigned* p, unsigned v) { return __hip_atomic_fetch_add(p, v, __ATOMIC_RELAXED, __HIP_MEMORY_SCOPE_AGENT); }
__device__ __forceinline__ unsigned xb_xcc_id() { return (unsigned)__builtin_amdgcn_s_getreg((3 << 11) | 20) & 0xFu; }
#define XB_SPIN(cond, bar) do { unsigned _sp = 0; while (cond) { __builtin_amdgcn_s_sleep(1); \
    if ((++_sp & 255u) == 0u) { if (xb_ld(&(bar)[XB_TMO])) break; if (_sp > XB_SPIN_CAP) { atomicAdd(&(bar)[XB_TMO], 1u); break; } } } } while (0)

struct XcdBarrier {
    unsigned* bar; unsigned x;
    volatile LAS unsigned* st;
};

__device__ __forceinline__ XcdBarrier xcd_barrier_post(unsigned* bar, volatile LAS unsigned* st) {
    XcdBarrier b; b.bar = bar; b.x = xb_xcc_id(); b.st = st;
    if (threadIdx.x == 0) (void)xb_add(&bar[XB_XCNT(b.x)], 1u);
    return b;
}
__device__ __forceinline__ void xcd_barrier_complete(unsigned* bar, unsigned x, unsigned& nloc, unsigned& nx) {
    const unsigned G = gridDim.x * gridDim.y * gridDim.z;
    unsigned sum, cnt, mine, sp = 0u;
    for (;;) {
        sum = 0u; cnt = 0u; mine = 0u;
#pragma unroll
        for (unsigned j = 0; j < 16; ++j) { const unsigned c = xb_ld(&bar[XB_XCNT(j)]); sum += c; cnt += (c > 0u) ? 1u : 0u; mine = (j == x) ? c : mine; }
        if (sum == G) break;
        __builtin_amdgcn_s_sleep(1);
        if ((++sp & 255u) == 0u) { if (xb_ld(&bar[XB_TMO])) break; if (sp > XB_SPIN_CAP) { atomicAdd(&bar[XB_TMO], 1u); break; } }
    }
    nloc = mine > 0u ? mine : 1u; nx = cnt > 0u ? cnt : 1u;
}

__device__ __forceinline__ void xcd_barrier(const XcdBarrier& b) {
    asm volatile("s_waitcnt vmcnt(0)" ::: "memory");
    __syncthreads();
    if (threadIdx.x == 0) {
        unsigned* bar = b.bar;
        __builtin_amdgcn_s_waitcnt(0);
        unsigned nloc = b.st[0], nx = b.st[1];
        if (nloc == 0u) { xcd_barrier_complete(bar, b.x, nloc, nx); b.st[0] = nloc; b.st[1] = nx; }
        const unsigned old = xb_add(&bar[XB_XSUB(b.x)], 1u);
        const unsigned gen = old / nloc;
        if (old + 1u == (gen + 1u) * nloc) {
            __builtin_amdgcn_fence(__ATOMIC_RELEASE, "agent");
            asm volatile("s_waitcnt vmcnt(0)" ::: "memory");
            const unsigned og = xb_add(&bar[XB_TOP], 1u);
            const unsigned tg = og / nx;
            if (og + 1u == (tg + 1u) * nx) xb_add(&bar[XB_TOPGEN], 1u);
            else XB_SPIN(xb_ld(&bar[XB_TOPGEN]) == tg, bar);
            __builtin_amdgcn_fence(__ATOMIC_ACQUIRE, "agent");
            xb_add(&bar[XB_XGEN(b.x)], 1u);
            asm volatile("s_waitcnt vmcnt(0)" ::: "memory");
        } else {
            XB_SPIN(xb_ld(&bar[XB_XGEN(b.x)]) == gen, bar);
            __builtin_amdgcn_fence(__ATOMIC_ACQUIRE, "agent");
            asm volatile("s_waitcnt vmcnt(0)" ::: "memory");
        }
    }
    __syncthreads();
}

struct Args {
    const float* x; const float* g_mix; const float* g_mlp; const float* fox_w_in; const float* fox_b_f; const float* fox_g_q; const float* fox_g_k; const float* fox_w_out;
    const float* sgu_w_in; const float* sgu_b_in; const float* sgu_g_v; const float* sgu_w_s; const float* sgu_b_s; const float* sgu_w_out; const float* mlp_w1; const float* mlp_w2;
    float* out; unsigned char* ws;
};

__global__ void __launch_bounds__(NWAVES * 64, 2) fwd_megakernel(Args a_unused) {
    extern __shared__ __attribute__((aligned(16))) unsigned char lds[];
    cg::grid_group grid = cg::this_grid();
    LAS unsigned char* ldsl = (LAS unsigned char*)lds;
#ifdef DBG_FENCE
#define GRID_SYNC() do { __threadfence(); grid.sync(); __threadfence(); } while (0)
#else
#define GRID_SYNC() do { asm volatile("s_waitcnt vmcnt(0)" ::: "memory"); grid.sync(); } while (0)
#endif
#define XSYNC() do { FRESH(kx_); XcdBarrier xb_; xb_.bar = (unsigned*)(kx_->ws + WS_CTL); xb_.x = xb_xcc_id(); xb_.st = (volatile LAS unsigned*)(ldsl + LDS_MISC); xcd_barrier(xb_); } while (0)
#define IDS() int tid = threadIdx.x, G = gridDim.x, bx = blockIdx.x; asm volatile("" : "+v"(tid), "+s"(G), "+s"(bx)); \
              const int lane = tid & 63, wave = __builtin_amdgcn_readfirstlane(tid >> 6), gw = bx * NWAVES + wave, NGW = G * NWAVES; (void)lane; (void)gw; (void)NGW
    typedef const __attribute__((address_space(4))) Args* KAp;
#define FRESH(ka) KAp ka = (KAp)__builtin_amdgcn_kernarg_segment_ptr(); asm volatile("" : "+s"(ka))
#define P_SSQ(ka) ((float*)((ka)->ws + WS_SSQ))
#define P_LF(ka) ((float*)((ka)->ws + WS_LF))
#define P_CUM(ka) ((float*)((ka)->ws + WS_C))
#define P_XB(ka) ((bf16*)((ka)->ws + WS_XB))
#define P_FWIN(ka) ((bf16*)((ka)->ws + WS_FWIN))
#define P_FWOUT(ka) ((bf16*)((ka)->ws + WS_FWOUT))
#define P_SWIN(ka) ((bf16*)((ka)->ws + WS_SWIN))
#define P_SWOUT(ka) ((bf16*)((ka)->ws + WS_SWOUT))
#define P_W1T(ka) ((bf16*)((ka)->ws + WS_W1))
#define P_W2T(ka) ((bf16*)((ka)->ws + WS_W2))
#define P_BIG(ka) ((bf16*)((ka)->ws + WS_BIG))
#define P_QKV(ka) P_BIG(ka)
#define P_OB(ka) (P_BIG(ka) + (size_t)M * NQKV)
#define P_UV(ka) P_BIG(ka)
#define P_GB(ka) (P_BIG(ka) + (size_t)M * NUV)
#define P_HB(ka) P_BIG(ka)

    { FRESH(a0_); if (threadIdx.x < 2) ((volatile LAS unsigned*)(ldsl + LDS_MISC))[threadIdx.x] = 0u;
      if (blockIdx.x == 0) { unsigned* cw = (unsigned*)(a0_->ws + WS_CTL); for (int i = threadIdx.x; i < XCD_BAR_WORDS; i += NWAVES * 64) cw[i] = 0u; }
      __syncthreads(); }
#ifdef DBG_LDSZERO
    { for (int i = threadIdx.x; i < LDS_BYTES / 16; i += NWAVES * 64) ((LAS v4u*)ldsl)[i] = (v4u){0u, 0u, 0u, 0u}; __syncthreads(); }
#endif
#ifndef REP_PRO
#define REP_PRO 1
#endif
    for (int rep_ = 0; rep_ < REP_PRO; ++rep_) {
        FRESH(a_); IDS();
        float* ssq = P_SSQ(a_); bf16* XB = P_XB(a_);
        bf16* FWIN = P_FWIN(a_); bf16* FWOUT = P_FWOUT(a_); bf16* SWIN = P_SWIN(a_); bf16* SWOUT = P_SWOUT(a_); bf16* W1T = P_W1T(a_); bf16* W2T = P_W2T(a_);
        LAS float* scr = (LAS float*)(ldsl + wave * 16640);
        constexpr int I_FWIN = (DM / 64) * ((NFOXW + 63) / 64), I_SQ = (DM / 64) * (DM / 64), I_SWIN = (DM / 64) * (NUV / 64), I_W1 = (DM / 64) * (FF / 64), I_W2 = (FF / 64) * (DM / 64);
        constexpr int NITEMS = 2 * I_FWIN + 2 * I_SQ + 2 * I_SWIN + 2 * I_SQ + 4 * I_W1 + 4 * I_W2;
        for (int it = gw; it < NITEMS; it += NGW) {
            int r = NITEMS - 1 - it;
            if (r < 2 * I_FWIN) { const int j = r / I_FWIN; r -= j * I_FWIN; p0_transpose_item(a_->fox_w_in + (size_t)j * DM * NFOXW, DM, NFOXW, a_->g_mix + (size_t)(2 * j) * DM, FWIN + (size_t)j * FWIN_STRIDE, scr, r, lane); continue; } r -= 2 * I_FWIN;
            if (r < 2 * I_SQ) { const int j = r / I_SQ; r -= j * I_SQ; p0_transpose_item(a_->fox_w_out + (size_t)j * DM * DM, DM, DM, nullptr, FWOUT + (size_t)j * DM * DM, scr, r, lane); continue; } r -= 2 * I_SQ;
            if (r < 2 * I_SWIN) { const int j = r / I_SWIN; r -= j * I_SWIN; p0_transpose_item(a_->sgu_w_in + (size_t)j * DM * NUV, DM, NUV, a_->g_mix + (size_t)(2 * j + 1) * DM, SWIN + (size_t)j * DM * NUV, scr, r, lane); continue; } r -= 2 * I_SWIN;
            if (r < 2 * I_SQ) { const int j = r / I_SQ; r -= j * I_SQ; p0_transpose_item(a_->sgu_w_out + (size_t)j * DM * DM, DM, DM, nullptr, SWOUT + (size_t)j * DM * DM, scr, r, lane); continue; } r -= 2 * I_SQ;
            if (r < 4 * I_W1) { const int j = r / I_W1; r -= j * I_W1; p0_transpose_item(a_->mlp_w1 + (size_t)j * DM * FF, DM, FF, a_->g_mlp + (size_t)j * DM, W1T + (size_t)j * DM * FF, scr, r, lane); continue; } r -= 4 * I_W1;
            { const int j = r / I_W2; r -= j * I_W2; p0_transpose_item(a_->mlp_w2 + (size_t)j * DM * FF, FF, DM, nullptr, W2T + (size_t)j * DM * FF, scr, r, lane); }
        }
        for (int m = gw; m < M; m += NGW) {
            const f32x4* xr = (const f32x4*)(a_->x + (size_t)m * DM) + lane; v2u* o8 = (v2u*)(XB + (size_t)m * DM) + lane; float s = 0.f;
#pragma unroll
            for (int j = 0; j < 8; ++j) { const f32x4 v = xr[64 * j]; s += (v[0] * v[0] + v[1] * v[1]) + (v[2] * v[2] + v[3] * v[3]); v2u w; w.x = pk2(v[0], v[1]); w.y = pk2(v[2], v[3]); o8[64 * j] = w; }
            s = wave_sum(s); if (lane == 0) { *(f32x4*)(ssq + (size_t)m * 8) = (f32x4){s, 0.f, 0.f, 0.f}; *(f32x4*)(ssq + (size_t)m * 8 + 4) = (f32x4){0.f, 0.f, 0.f, 0.f}; }
        }
    }
    GRID_SYNC();
    { FRESH(a1_); (void)xcd_barrier_post((unsigned*)(a1_->ws + WS_CTL), (volatile LAS unsigned*)(ldsl + LDS_MISC)); }
#ifndef WGM_G1F
#define WGM_G1F 4
#endif
#ifndef WGM_G1S
#define WGM_G1S 4
#endif
#ifndef WGM_G2
#define WGM_G2 4
#endif
#ifndef WGM_G3
#define WGM_G3 4
#endif
#ifndef WGM_G4
#define WGM_G4 4
#endif
    for (int layer = 0; layer < DEPTH; ++layer) {
        const int j = layer >> 1;
#define SSQ_MIX(ka) (P_SSQ(ka) + (size_t)(2 * layer) * M * 8)
#define SSQ_MLP(ka) (P_SSQ(ka) + (size_t)(2 * layer + 1) * M * 8)
#define SSQ_NXT(ka) (P_SSQ(ka) + (size_t)(2 * layer + 2) * M * 8)
        if ((layer & 1) == 0) {
#ifndef NO_GATE
#ifndef REP_GATE
#define REP_GATE 1
#endif
            for (int rep_ = 0; rep_ < REP_GATE; ++rep_) { FRESH(a); IDS(); const bf16* Win = P_FWIN(a) + (size_t)j * FWIN_STRIDE; const bf16* XB = P_XB(a); const float* ssq_mix = SSQ_MIX(a); float* LF = P_LF(a); const float* bfp = a->fox_b_f + j * NH;
            for (int task = gw; task < M / 16; task += NGW) {
                const int fr = lane & 15, kq = lane >> 4;
                const bf16* ap = Win + (size_t)(NQKV + fr) * DM + 8 * kq;
                const bf16* bp = XB + (size_t)(task * 16 + fr) * DM + 8 * kq;
                f32x4 acc = {0.f, 0.f, 0.f, 0.f};
#pragma unroll 8
                for (int kk = 0; kk < DM / 32; ++kk) acc = __builtin_amdgcn_mfma_f32_16x16x32_bf16(*(const bf16x8*)(ap + 32 * kk), *(const bf16x8*)(bp + 32 * kk), acc, 0, 0, 0);
                const int row = task * 16 + fr; const float rs = pg8::rstd_row(ssq_mix, row); f32x4 o;
#pragma unroll
                for (int e = 0; e < 4; ++e) { const float z = acc[e] * rs + bfp[4 * kq + e]; o[e] = fminf(z, 0.f) - log1pf(expf(-fabsf(z))); }
#pragma unroll
                for (int d = 1; d < 16; d <<= 1) { f32x4 t_; t_[0] = __shfl_up(o[0], d, 16); t_[1] = __shfl_up(o[1], d, 16); t_[2] = __shfl_up(o[2], d, 16); t_[3] = __shfl_up(o[3], d, 16); if (fr >= d) o += t_; }
                *(f32x4*)(LF + (size_t)row * 16 + 4 * kq) = o;
                if (fr == 15) *(f32x4*)(P_CUM(a) + (size_t)task * 16 + 4 * kq) = o;
            } }
#endif
#ifndef NO_G1F
#ifndef REP_G1F
#define REP_G1F 1
#endif
            for (int rep_ = 0; rep_ < REP_G1F; ++rep_) {
                FRESH(a); IDS(); pg8::Gemm g{P_XB(a), P_FWIN(a) + (size_t)j * FWIN_STRIDE, M, NQKV, DM}; pg8::StaticOrder S; S.init(M, NQKV, G, bx, WGM_G1F);
                #ifndef PROBE_QKVMODE
#define PROBE_QKVMODE 0
#endif
                pg8::EpiQKV E{P_QKV(a), SSQ_MIX(a), a->fox_g_q + j * HD, a->fox_g_k + j * HD, (LAS float*)(ldsl + LDS_X), (REP_G1F > 1 && rep_ == 0) ? PROBE_QKVMODE : 0};
                pg8::gemm_phase<pg8::EpiQKV, pg8::StaticOrder, true, true>(ldsl, g, S, E);
            }
#endif
            XSYNC();
#ifndef NO_ATT
#ifndef REP_ATT
#define REP_ATT 1
#endif
            for (int rep_ = 0; rep_ < REP_ATT; ++rep_) { FRESH(a); att::attn_phase((char*)lds, P_QKV(a), P_OB(a), P_LF(a), P_CUM(a)); }
#endif
            XSYNC();
        } else {
#ifndef NO_G1S
#ifndef REP_G1S
#define REP_G1S 1
#endif
            for (int rep_ = 0; rep_ < REP_G1S; ++rep_) {
                FRESH(a); IDS(); pg8::Gemm g{P_XB(a), P_SWIN(a) + (size_t)j * DM * NUV, M, NUV, DM}; pg8::StaticOrder S; S.init(M, NUV, G, bx, WGM_G1S);
                pg8::EpiAct<2> E{P_UV(a), NUV, a->sgu_b_in + (size_t)j * NUV, SSQ_MIX(a), 0};
                pg8::gemm_phase<pg8::EpiAct<2>, pg8::StaticOrder, true, true>(ldsl, g, S, E);
            }
#endif
            XSYNC();
#ifndef NO_SG
#ifndef REP_SG
#define REP_SG 1
#endif
            for (int rep_ = 0; rep_ < REP_SG; ++rep_) {
                FRESH(a); IDS(); const bf16* UV = P_UV(a); bf16* GB = P_GB(a); const float* g_v = a->sgu_g_v; const float* w_s = a->sgu_w_s; const float* b_s = a->sgu_b_s;
                LAS bf16* VT = (LAS bf16*)ldsl; constexpr int VP = 136;
                for (int unit = bx; unit < (M / 128) * 16; unit += G) {
                    const int ch = unit >> 4, gI = unit & 15;
                    {   const int s = tid >> 2, q4 = tid & 3;
                        const v4u* vp = (const v4u*)(UV + (size_t)(ch * 128 + s) * NUV + 2048 + gI * 128 + q4 * 32);
                        float f[32]; float ss = 0.f;
#pragma unroll
                        for (int c = 0; c < 4; ++c) { const v4u w = vp[c]; f[8 * c + 0] = bf_lo(w.x); f[8 * c + 1] = bf_hi(w.x); f[8 * c + 2] = bf_lo(w.y); f[8 * c + 3] = bf_hi(w.y);
                            f[8 * c + 4] = bf_lo(w.z); f[8 * c + 5] = bf_hi(w.z); f[8 * c + 6] = bf_lo(w.w); f[8 * c + 7] = bf_hi(w.w); }
#pragma unroll
                        for (int e = 0; e < 32; ++e) ss += f[e] * f[e];
                        ss += __shfl_xor(ss, 1); ss += __shfl_xor(ss, 2);
                        const float rv = __builtin_amdgcn_rsqf(ss * (1.0f / 128.0f) + EPS);
                        const float* gv = g_v + (size_t)j * DM + gI * 128 + q4 * 32;
#pragma unroll
                        for (int e = 0; e < 32; e += 2) { const unsigned w = pk2(f[e] * rv * gv[e], f[e + 1] * rv * gv[e + 1]);
                            VT[(q4 * 32 + e) * VP + s] = (bf16)(w & 0xffffu); VT[(q4 * 32 + e + 1) * VP + s] = (bf16)(w >> 16); }
                    }
                    __syncthreads();
                    {   const int fr = lane & 15, kq = lane >> 4, t = 16 * wave + fr, kmax = (16 * wave + 15) >> 5;
                        const float* wsrow = w_s + (((size_t)j * 16 + gI) * 128 + t) * 128;
                        bf16x8 bw[4];
#pragma unroll
                        for (int ks = 0; ks < 4; ++ks) { v4u w = {0u, 0u, 0u, 0u};
                            if (ks <= kmax) { const int s0 = 32 * ks + 8 * kq; const f32x4 lo = *(const f32x4*)(wsrow + s0), hi4 = *(const f32x4*)(wsrow + s0 + 4);
                                float e[8] = {lo[0], lo[1], lo[2], lo[3], hi4[0], hi4[1], hi4[2], hi4[3]};
#pragma unroll
                                for (int i = 0; i < 8; ++i) if (s0 + i > t) e[i] = 0.f;
                                w.x = pk2(e[0], e[1]); w.y = pk2(e[2], e[3]); w.z = pk2(e[4], e[5]); w.w = pk2(e[6], e[7]); }
                            bw[ks] = __builtin_bit_cast(bf16x8, w); }
                        const float bs = b_s[((size_t)j * 16 + gI) * 128 + t];
                        const size_t row = (size_t)ch * 128 + t;
                        v2u uws[8];
#pragma unroll
                        for (int nt = 0; nt < 8; ++nt) uws[nt] = *(const v2u*)(UV + row * NUV + gI * 128 + 16 * nt + 4 * kq);
#pragma unroll
                        for (int nt = 0; nt < 8; ++nt) { f32x4 acc = {0.f, 0.f, 0.f, 0.f};
#pragma unroll
                            for (int ks = 0; ks < 4; ++ks) if (ks <= kmax) { const bf16x8 av = *(const LAS bf16x8*)(VT + (16 * nt + fr) * VP + 32 * ks + 8 * kq);
                                acc = __builtin_amdgcn_mfma_f32_16x16x32_bf16(av, bw[ks], acc, 0, 0, 0); }
                            const int col = gI * 128 + 16 * nt + 4 * kq;
                            const v2u uw = uws[nt];
                            v2u o; o.x = pk2(bf_lo(uw.x) * (acc[0] + bs), bf_hi(uw.x) * (acc[1] + bs)); o.y = pk2(bf_lo(uw.y) * (acc[2] + bs), bf_hi(uw.y) * (acc[3] + bs));
                            *(v2u*)(GB + row * DM + col) = o; }
                    }
                    __syncthreads();
                }
            }
#endif
            XSYNC();
        }
#ifndef NO_G2
        {
            FRESH(a); IDS(); const bool fox = (layer & 1) == 0;
            const bf16* Amix = fox ? P_OB(a) : P_GB(a); const bf16* Wmix = (fox ? P_FWOUT(a) : P_SWOUT(a)) + (size_t)j * DM * DM;
            pg8::Gemm g{Amix, Wmix, M, DM, DM}; pg8::StaticOrder S; S.init(M, DM, G, bx, WGM_G2);
            pg8::EpiResid E{(layer == 0) ? a->x : (const float*)nullptr, (float*)nullptr, P_XB(a), SSQ_MLP(a), (LAS float*)(ldsl + LDS_X), (const float*)nullptr};
            pg8::gemm_phase<pg8::EpiResid, pg8::StaticOrder, true, true>(ldsl, g, S, E);
        }
#endif
        XSYNC();
#ifndef NO_G3
#ifndef REP_G3
#define REP_G3 1
#endif
#ifndef PROBE_NOSTORE
#define PROBE_NOSTORE 0
#endif
        for (int rep_ = 0; rep_ < REP_G3; ++rep_) {
            FRESH(a); IDS(); pg8::Gemm g{P_XB(a), P_W1T(a) + (size_t)layer * DM * FF, M, FF, DM}; pg8::StaticOrder S; S.init(M, FF, G, bx, WGM_G3);
            pg8::EpiAct<1> E{P_HB(a), FF, nullptr, SSQ_MLP(a), (REP_G3 > 1 && rep_ == 0 && PROBE_NOSTORE) ? 1 : 0};
            pg8::gemm_phase<pg8::EpiAct<1>, pg8::StaticOrder, true, true>(ldsl, g, S, E);
        }
#endif
        XSYNC();
#ifdef PROBE_G4D
        for (int rep_ = 0; rep_ < PROBE_G4D; ++rep_) {
            FRESH(a); IDS(); pg8::Gemm g{P_HB(a), P_W2T(a) + (size_t)layer * DM * FF, M, DM, FF}; pg8::StaticOrder S; S.init(M, DM, G, bx);
            pg8::EpiAct<1> E{P_HB(a), FF, nullptr, SSQ_MLP(a), 1};
            pg8::gemm_phase<pg8::EpiAct<1>, pg8::StaticOrder, true, true>(ldsl, g, S, E);
        }
#endif
#ifdef PROBE_G4R
        for (int rep_ = 0; rep_ < PROBE_G4R; ++rep_) {
            FRESH(a); IDS(); pg8::Gemm g{P_HB(a), P_W2T(a) + (size_t)layer * DM * FF, M, DM, FF}; pg8::StaticOrder S; S.init(M, DM, G, bx);
            pg8::EpiResid E{(const float*)nullptr, (float*)nullptr, (bf16*)(a->ws + 700 * MiB), (float*)(a->ws + 770 * MiB), (LAS float*)(ldsl + LDS_X), (const float*)SSQ_MLP(a)};
            pg8::gemm_phase<pg8::EpiResid, pg8::StaticOrder, true, true>(ldsl, g, S, E);
        }
#endif
#ifdef PROBE_G2R
        for (int rep_ = 0; rep_ < PROBE_G2R; ++rep_) {
            FRESH(a); IDS(); pg8::Gemm g{P_XB(a), P_FWOUT(a), M, DM, DM}; pg8::StaticOrder S; S.init(M, DM, G, bx);
            pg8::EpiResid E{(const float*)nullptr, (float*)nullptr, (bf16*)(a->ws + 700 * MiB), (float*)(a->ws + 770 * MiB), (LAS float*)(ldsl + LDS_X), (const float*)nullptr};
            pg8::gemm_phase<pg8::EpiResid, pg8::StaticOrder, true, true>(ldsl, g, S, E);
        }
#endif
#ifndef NO_G4
        {
            FRESH(a); IDS(); pg8::Gemm g{P_HB(a), P_W2T(a) + (size_t)layer * DM * FF, M, DM, FF}; pg8::StaticOrder S; S.init(M, DM, G, bx, WGM_G4);
            pg8::EpiResid E{(const float*)nullptr, (layer + 1 == DEPTH) ? a->out : (float*)nullptr, P_XB(a), SSQ_NXT(a), (LAS float*)(ldsl + LDS_X), (const float*)SSQ_MLP(a)};
            pg8::gemm_phase<pg8::EpiResid, pg8::StaticOrder, true, true>(ldsl, g, S, E);
        }
#endif
        if (layer + 1 < DEPTH) XSYNC();
    }
}

extern "C" void kernel_launch(void* const* d_in, const int* in_sizes, int n_in, void* d_out, int out_size, void* d_ws, size_t ws_size, hipStream_t stream) {
    static int grid = 0;
    if (grid == 0) {
        if (n_in != 16 || in_sizes[0] != M * DM || out_size != M * DM || ws_size < WS_END) { fprintf(stderr, "kernel_launch: unexpected shapes (n_in %d in0 %d out %d ws %zu)\n", n_in, n_in > 0 ? in_sizes[0] : -1, out_size, ws_size); grid = -1; return; }
        int dev = 0, cus = 0, per_cu = 0;
        (void)hipGetDevice(&dev); (void)hipDeviceGetAttribute(&cus, hipDeviceAttributeMultiprocessorCount, dev);
        if (hipFuncSetAttribute((const void*)fwd_megakernel, hipFuncAttributeMaxDynamicSharedMemorySize, LDS_BYTES) != hipSuccess) { fprintf(stderr, "kernel_launch: hipFuncSetAttribute failed\n"); grid = -1; return; }
        if (hipOccupancyMaxActiveBlocksPerMultiprocessor(&per_cu, (const void*)fwd_megakernel, NWAVES * 64, LDS_BYTES) != hipSuccess || per_cu < 1) { fprintf(stderr, "kernel_launch: occupancy query says %d\n", per_cu); per_cu = 1; }
        (void)hipGetLastError();
        grid = cus * 1;
        if (grid <= 0) grid = 256;
    }
    if (grid < 0) return;
    Args a{};
    a.x = (const float*)d_in[0]; a.g_mix = (const float*)d_in[1]; a.g_mlp = (const float*)d_in[2]; a.fox_w_in = (const float*)d_in[3]; a.fox_b_f = (const float*)d_in[4];
    a.fox_g_q = (const float*)d_in[5]; a.fox_g_k = (const float*)d_in[6]; a.fox_w_out = (const float*)d_in[7]; a.sgu_w_in = (const float*)d_in[8]; a.sgu_b_in = (const float*)d_in[9];
    a.sgu_g_v = (const float*)d_in[10]; a.sgu_w_s = (const float*)d_in[11]; a.sgu_b_s = (const float*)d_in[12]; a.sgu_w_out = (const float*)d_in[13]; a.mlp_w1 = (const float*)d_in[14]; a.mlp_w2 = (const float*)d_in[15];
    a.out = (float*)d_out; a.ws = (unsigned char*)d_ws;
#ifdef DBG_MEMSET
    (void)hipMemsetAsync(d_ws, 0x55, WS_END, stream); (void)hipMemsetAsync(d_out, 0x55, (size_t)M * DM * 4, stream);
#endif
    void* args[] = {&a};
    hipError_t e = hipLaunchCooperativeKernel((const void*)fwd_megakernel, dim3(grid), dim3(NWAVES * 64), args, LDS_BYTES, stream);
    if (e != hipSuccess) fprintf(stderr, "kernel_launch: cooperative launch failed: %s (grid %d)\n", hipGetErrorString(e), grid);
}
```

```cpp
#include <hip/hip_runtime.h>
#include <hip/hip_cooperative_groups.h>
#include <cstdio>
#include <cstdint>
namespace cg = cooperative_groups;
namespace pg8 {
#define PG8_LAS __attribute__((address_space(3)))
typedef unsigned short bf16_t;
typedef short bf16x8 __attribute__((ext_vector_type(8)));
typedef float f32x4 __attribute__((ext_vector_type(4)));
typedef unsigned u32x4 __attribute__((ext_vector_type(4)));
constexpr int BM = 256, BK = 64, HALF = 128, HTB = HALF * BK * 2  , STAGE_BYTES = 8 * HTB, NXCD = 8, WGM = 8;

__host__ __device__ __forceinline__ int lds_byte(int r, int c) { const int st = (r >> 4) * 2 + (c >> 5), rr = r & 15, cc = c & 31, ob = rr * 64 + cc * 2; return st * 1024 + (ob ^ (((ob >> 9) & 1) << 5)); }
__host__ __device__ __forceinline__ void stage_rc(int b, int& R, int& C) { const int st = b / 1024, sb = b % 1024, swz = sb ^ (((sb >> 9) & 1) << 5); R = (st >> 1) * 16 + swz / 64; C = (st & 1) * 32 + (swz % 64) / 2; }
__host__ __device__ __forceinline__ int perm32(int rho) { const int n = rho >> 4, i = rho & 15; return 8 * (i >> 2) + 4 * n + (i & 3); }

struct Unit { int pm, pn; };
struct Gemm { const bf16_t* A; const bf16_t* Bt; int M, N, K; };

struct StaticOrder {
    int nM, nN, nwg, G, c, wgm;
    __host__ __device__ void init(int M, int N, int G_, int c_, int wgm_ = WGM) { nM = M / BM; nN = N / BM; nwg = nM * nN; G = G_; c = c_; wgm = wgm_; }
    __host__ __device__ bool next(int i, Unit& u) const {
        const long L = (long)i * G + c; if (L >= nwg) return false;
        int wgid = (int)L; { const int q = nwg / NXCD, r = nwg % NXCD, xcd = wgid % NXCD, off = wgid / NXCD; wgid = (xcd < r ? xcd * (q + 1) : r * (q + 1) + (xcd - r) * q) + off; }
        const int nig = wgm * nN, gid = wgid / nig, fm = gid * wgm, gsz = (nM - fm) < wgm ? (nM - fm) : wgm;
        u.pm = fm + ((wgid % nig) % gsz); u.pn = (wgid % nig) / gsz; return true;
    }
    __device__ __forceinline__ void a_ready(const Unit&) const {}
    __device__ __forceinline__ void done(const Unit&) const {}
};

__device__ __forceinline__ unsigned cvt_pk_bf16(float lo, float hi) { unsigned r; asm volatile("v_cvt_pk_bf16_f32 %0, %1, %2" : "=v"(r) : "v"(lo), "v"(hi)); return r; }
typedef float f32x2 __attribute__((ext_vector_type(2)));
typedef unsigned u32x2 __attribute__((ext_vector_type(2)));
__device__ __forceinline__ float rstd_row(const float* part, int row) { const f32x4 a = *(const f32x4*)(part + (size_t)row * 8), b = *(const f32x4*)(part + (size_t)row * 8 + 4);
    return __builtin_amdgcn_rsqf((((a[0] + a[1]) + (a[2] + a[3])) + ((b[0] + b[1]) + (b[2] + b[3]))) * (1.0f / 2048.0f) + 1e-6f); }
__device__ __forceinline__ float act_relu2(float v) { const float r = fmaxf(v, 0.f); return r * r; }
__device__ __forceinline__ float act_gelu_tanh(float x) {
    const float u = 0.7978845608028654f * (x + 0.044715f * x * x * x);
    const float t = __builtin_amdgcn_exp2f(u * 2.8853900817779268f);
    return x - x * __builtin_amdgcn_rcpf(t + 1.0f);
}
#ifdef WT_STORES
__device__ __forceinline__ void st16(void* p, u32x4 w) { asm volatile("global_store_dwordx4 %0, %1, off sc0 sc1\n\ts_nop 1" :: "v"(p), "v"(w) : "memory"); }
#else
__device__ __forceinline__ void st16(void* p, u32x4 w) { *(u32x4*)p = w; }
#endif
template <int ACT> struct EpiAct {
    static constexpr bool PERM = true, AFTER_DRAIN = false;
    bf16_t* O; int ldc; const float* bias; const float* ssq; int nostore;
    __device__ __forceinline__ void operator()(const f32x4 (&acc)[2][2][4][2], const Unit& u, int wr, int wc, int fr, int fq) const {
        const int row0 = u.pm * BM + wr * 64 + fr; const int col0 = u.pn * BM + wc * 32 + 8 * fq;
        f32x4 bv[2][2];
#pragma unroll
        for (int bj = 0; bj < 2; ++bj)
#pragma unroll
            for (int n = 0; n < 2; ++n) bv[bj][n] = bias ? *(const f32x4*)(bias + col0 + bj * HALF + 4 * n) : (f32x4){0.f, 0.f, 0.f, 0.f};
#pragma unroll
        for (int ai = 0; ai < 2; ++ai)
#pragma unroll
            for (int m = 0; m < 4; ++m) { const int row = row0 + ai * HALF + m * 16; const float rs = (ACT == 1) ? 1.f : rstd_row(ssq, row); bf16_t* rowp = O + (size_t)row * ldc + col0;
#pragma unroll
                for (int bj = 0; bj < 2; ++bj) { f32x4 v0, v1;
                    if (ACT == 1) { const f32x4 a0 = acc[ai][bj][m][0], a1 = acc[ai][bj][m][1]; const float rs2 = rs * rs;
                        v0 = (f32x4){act_relu2(a0[0]), act_relu2(a0[1]), act_relu2(a0[2]), act_relu2(a0[3])} * rs2; v1 = (f32x4){act_relu2(a1[0]), act_relu2(a1[1]), act_relu2(a1[2]), act_relu2(a1[3])} * rs2; }
                    else { v0 = acc[ai][bj][m][0] * rs + bv[bj][0]; v1 = acc[ai][bj][m][1] * rs + bv[bj][1]; }
                    if (0) { v0 = (f32x4){act_relu2(v0[0]), act_relu2(v0[1]), act_relu2(v0[2]), act_relu2(v0[3])}; v1 = (f32x4){act_relu2(v1[0]), act_relu2(v1[1]), act_relu2(v1[2]), act_relu2(v1[3])}; }
                    if (ACT == 2) { v0 = (f32x4){act_gelu_tanh(v0[0]), act_gelu_tanh(v0[1]), act_gelu_tanh(v0[2]), act_gelu_tanh(v0[3])}; v1 = (f32x4){act_gelu_tanh(v1[0]), act_gelu_tanh(v1[1]), act_gelu_tanh(v1[2]), act_gelu_tanh(v1[3])}; }
                    u32x4 w; w.x = cvt_pk_bf16(v0[0], v0[1]); w.y = cvt_pk_bf16(v0[2], v0[3]); w.z = cvt_pk_bf16(v1[0], v1[1]); w.w = cvt_pk_bf16(v1[2], v1[3]);
                    if (!nostore) st16(rowp + bj * HALF, w); } }
    }
};
struct EpiQKV {
    static constexpr bool PERM = true, AFTER_DRAIN = false;
    bf16_t* QH; const float* ssq; const float* gq; const float* gk; PG8_LAS float* X; int mode;
    __device__ __forceinline__ void operator()(const f32x4 (&acc)[2][2][4][2], const Unit& u, int wr, int wc, int fr, int fq) const {
        const int sec = (mode & 1) ? 2 : (u.pn >> 3); const int row0 = u.pm * BM + wr * 64 + fr;
        if (sec < 2) {
#pragma unroll
            for (int ai = 0; ai < 2; ++ai)
#pragma unroll
                for (int m = 0; m < 4; ++m)
#pragma unroll
                    for (int bj = 0; bj < 2; ++bj) { const f32x4 a0 = acc[ai][bj][m][0], a1 = acc[ai][bj][m][1];
                        float s = ((a0[0] * a0[0] + a0[1] * a0[1]) + (a0[2] * a0[2] + a0[3] * a0[3])) + ((a1[0] * a1[0] + a1[1] * a1[1]) + (a1[2] * a1[2] + a1[3] * a1[3]));
                        s += __shfl_xor(s, 16); s += __shfl_xor(s, 32);
                        if (fq == 0) X[((ai * HALF + wr * 64 + m * 16 + fr) * 2 + bj) * 4 + wc] = s; }
            asm volatile("s_waitcnt lgkmcnt(0)\n\ts_barrier" ::: "memory");
        }
        int dcol = wc * 32 + 8 * fq; asm volatile("" : "+v"(dcol));
        f32x4 g0 = {1.f, 1.f, 1.f, 1.f}, g1 = {1.f, 1.f, 1.f, 1.f};
        if (sec == 0) { const int d = dcol; const f32x4 q0 = *(const f32x4*)(gq + d), q1 = *(const f32x4*)(gq + d + 4), k0 = *(const f32x4*)(gk + d), k1 = *(const f32x4*)(gk + d + 4);
            g0 = q0 * k0 * (0.08838834764831845f * 1.4426950408889634f); g1 = q1 * k1 * (0.08838834764831845f * 1.4426950408889634f); }
        bf16_t* sbase = QH + (size_t)sec * ((size_t)32 * 8192 * 128) + dcol;
#pragma unroll
        for (int ai = 0; ai < 2; ++ai)
#pragma unroll
            for (int m = 0; m < 4; ++m) { const int row = row0 + ai * HALF + m * 16; const int b = row >> 13, s = row & 8191; const float rs = rstd_row(ssq, row);
#pragma unroll
                for (int bj = 0; bj < 2; ++bj) { const int head = (u.pn & 7) * 2 + bj; float fac = rs;
                    if (sec < 2) { const f32x4 p = *(const PG8_LAS f32x4*)(X + ((ai * HALF + wr * 64 + m * 16 + fr) * 2 + bj) * 4);
                        fac = rs * __builtin_amdgcn_rsqf(((p[0] + p[1]) + (p[2] + p[3])) * (rs * rs) * (1.0f / 128.0f) + 1e-6f); }
                    const f32x4 v0 = acc[ai][bj][m][0] * fac * g0, v1 = acc[ai][bj][m][1] * fac * g1;
                    u32x4 w; w.x = cvt_pk_bf16(v0[0], v0[1]); w.y = cvt_pk_bf16(v0[2], v0[3]); w.z = cvt_pk_bf16(v1[0], v1[1]); w.w = cvt_pk_bf16(v1[2], v1[3]);
                    if (!(mode & 2)) st16(sbase + ((size_t)(b * 16 + head) * 8192 + s) * 128, w); } }
    }
};
struct EpiResid {
    static constexpr bool PERM = true, AFTER_DRAIN = false;
    const float* xin32; float* out32; bf16_t* xb; float* part; PG8_LAS float* X; const float* scale_part;
    __device__ __forceinline__ void operator()(const f32x4 (&acc)[2][2][4][2], const Unit& u, int wr, int wc, int fr, int fq) const {
        const int row0 = u.pm * BM + wr * 64 + fr; const int col0 = u.pn * BM + wc * 32 + 8 * fq;
#pragma unroll
        for (int ai = 0; ai < 2; ++ai)
#pragma unroll
            for (int m = 0; m < 4; ++m) { const int row = row0 + ai * HALF + m * 16; const size_t off = (size_t)row * 2048 + col0; float s = 0.f; float sc2 = 1.f;
                if (scale_part) { const float r_ = rstd_row(scale_part, row); sc2 = r_ * r_; }
#pragma unroll
                for (int bj = 0; bj < 2; ++bj) { f32x4 x0, x1;
                    if (xin32) { x0 = *(const f32x4*)(xin32 + off + bj * HALF); x1 = *(const f32x4*)(xin32 + off + bj * HALF + 4); }
                    else { const u32x4 w = *(const u32x4*)(xb + off + bj * HALF);
                        x0 = (f32x4){__uint_as_float(w.x << 16), __uint_as_float(w.x & 0xffff0000u), __uint_as_float(w.y << 16), __uint_as_float(w.y & 0xffff0000u)};
                        x1 = (f32x4){__uint_as_float(w.z << 16), __uint_as_float(w.z & 0xffff0000u), __uint_as_float(w.w << 16), __uint_as_float(w.w & 0xffff0000u)}; }
                    const f32x4 v0 = x0 + acc[ai][bj][m][0] * sc2, v1 = x1 + acc[ai][bj][m][1] * sc2;
                    if (out32) { *(f32x4*)(out32 + off + bj * HALF) = v0; *(f32x4*)(out32 + off + bj * HALF + 4) = v1; }
                    s += ((v0[0] * v0[0] + v0[1] * v0[1]) + (v0[2] * v0[2] + v0[3] * v0[3])) + ((v1[0] * v1[0] + v1[1] * v1[1]) + (v1[2] * v1[2] + v1[3] * v1[3]));
                    u32x4 w; w.x = cvt_pk_bf16(v0[0], v0[1]); w.y = cvt_pk_bf16(v0[2], v0[3]); w.z = cvt_pk_bf16(v1[0], v1[1]); w.w = cvt_pk_bf16(v1[2], v1[3]);
                    if (!out32) st16(xb + off + bj * HALF, w); }
                if (!out32) { s += __shfl_xor(s, 16); s += __shfl_xor(s, 32);
                if (fq == 0) X[(ai * HALF + wr * 64 + m * 16 + fr) * 4 + wc] = s; }
                asm volatile("" ::: "memory"); }
        if (out32) return;
        asm volatile("s_waitcnt lgkmcnt(0)\n\ts_barrier" ::: "memory");
        { int t = threadIdx.x; asm volatile("" : "+v"(t)); if (t < BM) { const f32x4 v = *(const PG8_LAS f32x4*)(X + t * 4); part[(size_t)(u.pm * BM + t) * 8 + u.pn] = (v[0] + v[1]) + (v[2] + v[3]); } }
    }
};
template <class Epi, class Sched, bool ALIGN_EPI = false, bool SP2 = false>
__device__ __forceinline__ void gemm_phase(PG8_LAS unsigned char* lds, const Gemm g, const Sched& S, const Epi& E) {
    int tid_raw = threadIdx.x; asm volatile("" : "+v"(tid_raw));
    const int tid = tid_raw, wid = __builtin_amdgcn_readfirstlane(tid >> 6), lane = tid & 63, wr = wid >> 2, wc = wid & 3, fr = lane & 15, fq = lane >> 4;
    const int K = g.K, nt = K / BK;
    unsigned voffA[2], voffB[2];
#pragma unroll
    for (int i = 0; i < 2; ++i) { int R, C; stage_rc(tid * 16 + i * 8192, R, C); const int Rb = Epi::PERM ? ((R & ~31) + perm32(R & 31)) : R;
        voffA[i] = (unsigned)(R * K + C) * 2u; voffB[i] = (unsigned)(Rb * K + C) * 2u; }
    const size_t kstep = (size_t)(BK * 2);
    const size_t hstep = (size_t)HALF * K * 2;
    const size_t tstep = 2 * hstep;
    const unsigned ldsw = (unsigned)wid * 1024u;
    const int aoff = lds_byte(wr * 64 + fr, fq * 8), boff = lds_byte(wc * 32 + fr, fq * 8);
#define PG8_SA(b, h) (((b) * 2 + (h)) * HTB)
#define PG8_SB(b, h) ((4 + (b) * 2 + (h)) * HTB)
#ifndef PG8_AUX_voffA
#define PG8_AUX_voffA 0
#endif
#ifndef PG8_AUX_voffB
#define PG8_AUX_voffB 0
#endif
#define PG8_STAGE(bufoff, gbase, voff) do { _Pragma("unroll") for (int _i = 0; _i < 2; ++_i) \
        __builtin_amdgcn_global_load_lds((const unsigned*)((const char*)(gbase) + (voff)[_i]), (PG8_LAS unsigned*)(lds + (bufoff) + ldsw + _i * 8192), 16, 0, PG8_AUX_##voff); } while (0)
#define PG8_LDA(dst, b, h) do { _Pragma("unroll") for (int m = 0; m < 4; ++m) _Pragma("unroll") for (int k = 0; k < 2; ++k) dst[m][k] = *(const PG8_LAS bf16x8*)(lds + PG8_SA(b, h) + aoff + m * 2048 + k * 1024); } while (0)
#define PG8_LDB(dst, b, h) do { _Pragma("unroll") for (int n = 0; n < 2; ++n) _Pragma("unroll") for (int k = 0; k < 2; ++k) dst[n][k] = *(const PG8_LAS bf16x8*)(lds + PG8_SB(b, h) + boff + n * 2048 + k * 1024); } while (0)
#define PG8_MMA(ai, bj, At, Bt) do { __builtin_amdgcn_s_setprio(1); _Pragma("unroll") for (int m = 0; m < 4; ++m) _Pragma("unroll") for (int n = 0; n < 2; ++n) _Pragma("unroll") for (int k = 0; k < 2; ++k) \
        acc[ai][bj][m][n] = __builtin_amdgcn_mfma_f32_16x16x32_bf16(Bt[n][k], At[m][k], acc[ai][bj][m][n], 0, 0, 0); __builtin_amdgcn_s_setprio(0); } while (0)
#define PG8_WAIT_V(n) asm volatile("s_waitcnt vmcnt(" #n ")" ::: "memory")
#define PG8_WAIT_L(n) asm volatile("s_waitcnt lgkmcnt(" #n ")" ::: "memory")
#define PG8_BAR __builtin_amdgcn_s_barrier()
#define PG8_SCHED __builtin_amdgcn_sched_barrier(0)
    Unit cur, nxt; int ui = 0;
    if (!S.next(0, cur)) return;
    f32x4 acc[2][2][4][2];
#pragma unroll
    for (int a = 0; a < 2; ++a)
#pragma unroll
        for (int b = 0; b < 2; ++b)
#pragma unroll
            for (int m = 0; m < 4; ++m)
#pragma unroll
                for (int n = 0; n < 2; ++n) acc[a][b][m][n] = (f32x4){0.f, 0.f, 0.f, 0.f};
    bf16x8 At[4][2], B0[2][2], B1[2][2];
    const char* cA = (const char*)g.A + (size_t)cur.pm * tstep; const char* cB = (const char*)g.Bt + (size_t)cur.pn * tstep;
    S.a_ready(cur);
    if constexpr (SP2) {
        PG8_STAGE(PG8_SB(0, 0), cB, voffB); PG8_STAGE(PG8_SB(0, 1), cB + hstep, voffB); PG8_STAGE(PG8_SA(0, 0), cA, voffA); PG8_STAGE(PG8_SA(0, 1), cA + hstep, voffA);
        if (wr == 1) PG8_BAR;
        PG8_WAIT_V(2); PG8_BAR;
        PG8_STAGE(PG8_SB(1, 0), cB + kstep, voffB); PG8_STAGE(PG8_SA(1, 0), cA + kstep, voffA); PG8_STAGE(PG8_SB(1, 1), cB + hstep + kstep, voffB);
        PG8_WAIT_V(6); PG8_BAR;
    } else {
        PG8_STAGE(PG8_SB(0, 0), cB, voffB); PG8_STAGE(PG8_SA(0, 0), cA, voffA); PG8_STAGE(PG8_SB(0, 1), cB + hstep, voffB); PG8_STAGE(PG8_SA(0, 1), cA + hstep, voffA);
        if (wr == 1) PG8_BAR;
        PG8_WAIT_V(4); PG8_BAR;
        PG8_STAGE(PG8_SB(1, 0), cB + kstep, voffB); PG8_STAGE(PG8_SA(1, 0), cA + kstep, voffA); PG8_STAGE(PG8_SB(1, 1), cB + hstep + kstep, voffB);
        PG8_WAIT_V(6); PG8_BAR;
    }
    for (;;) {
        const bool has_next = S.next(ui + 1, nxt);
        const char* nA = has_next ? (const char*)g.A + (size_t)nxt.pm * tstep : cA; const char* nB = has_next ? (const char*)g.Bt + (size_t)nxt.pn * tstep : cB;
        for (int t = 0; t < nt; t += 2) {
            const bool last = (t == nt - 2);
            const char* a1 = cA + (size_t)(t + 1) * kstep;
            const char* a2 = last ? nA : cA + (size_t)(t + 2) * kstep; const char* b2 = last ? nB : cB + (size_t)(t + 2) * kstep;
            const char* a3 = a2 + kstep; const char* b3 = b2 + kstep;
            if (last && has_next) S.a_ready(nxt);
            if constexpr (SP2) {
            PG8_LDB(B0, 0, 0); PG8_LDB(B1, 0, 1); PG8_SCHED; PG8_LDA(At, 0, 0); PG8_STAGE(PG8_SA(1, 1), a1 + hstep, voffA);
            PG8_WAIT_V(8); PG8_WAIT_L(0); PG8_BAR; PG8_MMA(0, 0, At, B0); PG8_MMA(0, 1, At, B1); PG8_BAR; PG8_SCHED;
            PG8_LDA(At, 0, 1); PG8_STAGE(PG8_SB(0, 0), b2, voffB); PG8_STAGE(PG8_SB(0, 1), b2 + hstep, voffB); PG8_STAGE(PG8_SA(0, 0), a2, voffA);
            PG8_WAIT_V(8); PG8_WAIT_L(0); PG8_BAR; PG8_MMA(1, 0, At, B0); PG8_MMA(1, 1, At, B1); PG8_BAR; PG8_SCHED;
            PG8_LDB(B0, 1, 0); PG8_LDB(B1, 1, 1); PG8_SCHED; PG8_LDA(At, 1, 0); PG8_STAGE(PG8_SA(0, 1), a2 + hstep, voffA);
            PG8_WAIT_V(8); PG8_WAIT_L(0); PG8_BAR; PG8_MMA(0, 0, At, B0); PG8_MMA(0, 1, At, B1); PG8_BAR; PG8_SCHED;
            PG8_LDA(At, 1, 1); PG8_STAGE(PG8_SB(1, 0), b3, voffB); PG8_STAGE(PG8_SB(1, 1), b3 + hstep, voffB); PG8_STAGE(PG8_SA(1, 0), a3, voffA);
            PG8_WAIT_V(8); PG8_WAIT_L(0); PG8_BAR; PG8_MMA(1, 0, At, B0); PG8_MMA(1, 1, At, B1); PG8_BAR; PG8_SCHED;
            } else {
            PG8_LDB(B0, 0, 0); PG8_SCHED; PG8_LDA(At, 0, 0); PG8_STAGE(PG8_SA(1, 1), a1 + hstep, voffA);
            PG8_WAIT_L(8); PG8_BAR; PG8_WAIT_L(0); PG8_MMA(0, 0, At, B0); PG8_BAR; PG8_SCHED;
            PG8_LDB(B1, 0, 1); PG8_STAGE(PG8_SB(0, 0), b2, voffB);
            PG8_BAR; PG8_WAIT_L(0); PG8_MMA(0, 1, At, B1); PG8_BAR;
            PG8_LDA(At, 0, 1); PG8_STAGE(PG8_SA(0, 0), a2, voffA);
            PG8_BAR; PG8_WAIT_L(0); PG8_MMA(1, 0, At, B0); PG8_BAR; PG8_SCHED;
            PG8_STAGE(PG8_SB(0, 1), b2 + hstep, voffB);
            PG8_WAIT_V(6); PG8_BAR; PG8_MMA(1, 1, At, B1); PG8_BAR;
            PG8_LDB(B0, 1, 0); PG8_SCHED; PG8_LDA(At, 1, 0); PG8_STAGE(PG8_SA(0, 1), a2 + hstep, voffA);
            PG8_WAIT_L(8); PG8_BAR; PG8_WAIT_L(0); PG8_MMA(0, 0, At, B0); PG8_BAR; PG8_SCHED;
            PG8_LDB(B1, 1, 1); PG8_STAGE(PG8_SB(1, 0), b3, voffB);
            PG8_BAR; PG8_WAIT_L(0); PG8_MMA(0, 1, At, B1); PG8_BAR;
            PG8_LDA(At, 1, 1); PG8_STAGE(PG8_SA(1, 0), a3, voffA);
            PG8_BAR; PG8_WAIT_L(0); PG8_MMA(1, 0, At, B0); PG8_BAR; PG8_SCHED;
            PG8_STAGE(PG8_SB(1, 1), b3 + hstep, voffB);
            PG8_WAIT_V(6); PG8_BAR; PG8_MMA(1, 1, At, B1); PG8_BAR;
            }
        }
        if constexpr (ALIGN_EPI) { if (wr == 0) PG8_BAR; }
        if constexpr (!Epi::AFTER_DRAIN) { E(acc, cur, wr, wc, fr, fq); S.done(cur); }
        if (!has_next) break;
#pragma unroll
        for (int a = 0; a < 2; ++a)
#pragma unroll
            for (int b = 0; b < 2; ++b)
#pragma unroll
                for (int m = 0; m < 4; ++m)
#pragma unroll
                    for (int n = 0; n < 2; ++n) acc[a][b][m][n] = (f32x4){0.f, 0.f, 0.f, 0.f};
        cur = nxt; cA = nA; cB = nB; ++ui;
        if constexpr (ALIGN_EPI) { if (wr == 1) PG8_BAR; }
    }
    PG8_WAIT_V(0);
    if constexpr (!ALIGN_EPI) { if (wr == 0) PG8_BAR; }
    PG8_BAR;
    if constexpr (Epi::AFTER_DRAIN) { E.fused(acc, cur, wr, wc, fr, fq, lds, wid, lane); S.done(cur); }
#undef PG8_SA
#undef PG8_SB
#undef PG8_STAGE
#undef PG8_LDA
#undef PG8_LDB
#undef PG8_MMA
#undef PG8_WAIT_V
#undef PG8_WAIT_L
#undef PG8_BAR
#undef PG8_SCHED
}
}
namespace att {
typedef unsigned short bf16;
typedef short bf16x8 __attribute__((ext_vector_type(8)));
typedef short s16x4 __attribute__((ext_vector_type(4)));
typedef float f32x16 __attribute__((ext_vector_type(16)));
typedef float f32x4 __attribute__((ext_vector_type(4)));
typedef unsigned u32x4 __attribute__((ext_vector_type(4)));
constexpr int D = 128, PQ = 128, PO = 2048, SEQ = 8192;
constexpr size_t SECB = (size_t)32 * 8192 * 128 * 2;
constexpr float THR = 8.f, LOG2E = 1.4426950408889634f;
constexpr int NW = 8, QBLK = 32, KVBLK = 64, QB = NW * QBLK;
constexpr int SHM_V = KVBLK * D * 2, SHM_K = KVBLK * D * 2;
constexpr int OFF_K = 3 * SHM_V;
constexpr int OFF_WS = 3 * SHM_V + 2 * SHM_K, OFF_CB = OFF_WS + NW * 64 * 4, LDS_BYTES = OFF_CB + SEQ * 4;
#define KSWZ(row, colB) ((row) * 256 + ((colB) ^ (((row) & 7) << 4)))
#define SBAR() __builtin_amdgcn_sched_barrier(0)
__device__ __forceinline__ int v_st(int k, int c) { const int kk = (k & ~0xC) | ((k & 4) << 1) | ((k & 8) >> 1); return ((kk >> 3) * 4 + (c >> 5)) * 512 + ((kk & 7) * 32 + (c & 31)) * 2; }
__device__ __forceinline__ int v_rd_base(int lane) { return ((lane & 3) << 3) | (((lane >> 2) & 3) << 6) | (((lane >> 4) & 1) << 5) | (((lane >> 5) & 1) << 8); }
constexpr int v_rd_off(int d0, int ks, int half) { return d0 * 512 + ks * 4096 + half * 2048; }
__device__ __forceinline__ int crow(int r, int hi) { return (r & 3) + 8 * (r >> 2) + 4 * hi; }
__device__ __forceinline__ unsigned cvtpk(float lo, float hi) { unsigned r; asm volatile("v_cvt_pk_bf16_f32 %0, %1, %2" : "=v"(r) : "v"(lo), "v"(hi)); return r; }
__device__ __forceinline__ bf16x8 ld8(const bf16* p) { return *reinterpret_cast<const bf16x8*>(p); }
__device__ __forceinline__ void mask_tile(f32x16& p0, f32x16& p1, int dq) {
    const float NEG = -__builtin_inff();
#pragma unroll
    for (int r = 0; r < 16; ++r) { const int c = (r & 3) + 8 * (r >> 2); if (dq - c < 0) p0[r] = NEG; if (dq - c - 32 < 0) p1[r] = NEG; }
}
__device__ __forceinline__ void partialSM(f32x16& p0, f32x16& p1, float& m_reg, float& mn, float& alpha) {
    float pmax = p0[0];
#pragma unroll
    for (int r = 1; r < 16; ++r) pmax = fmaxf(pmax, p0[r]);
#pragma unroll
    for (int r = 0; r < 16; ++r) pmax = fmaxf(pmax, p1[r]);
    { auto rr = __builtin_amdgcn_permlane32_swap(__float_as_uint(pmax), __float_as_uint(pmax), false, false); pmax = fmaxf(__uint_as_float(rr[0]), __uint_as_float(rr[1])); }
    if (__builtin_expect(__all((pmax - m_reg) <= THR), 1)) { mn = m_reg; alpha = 1.f; }
    else { mn = fmaxf(m_reg, pmax); alpha = __builtin_amdgcn_exp2f(m_reg - mn); m_reg = mn; }
#pragma unroll
    for (int r = 0; r < 16; ++r) { p0[r] -= mn; p1[r] -= mn; }
#pragma unroll
    for (int r = 0; r < 16; ++r) p0[r] = __builtin_amdgcn_exp2f(p0[r]);
}
__device__ __forceinline__ void finishSM(f32x16& p0, f32x16& p1, float alpha, float& l_reg, bf16x8& pa0, bf16x8& pa1, bf16x8& pa2, bf16x8& pa3) {
#pragma unroll
    for (int r = 0; r < 16; ++r) p1[r] = __builtin_amdgcn_exp2f(p1[r]);
    float ps = 0;
#pragma unroll
    for (int r = 0; r < 16; ++r) ps += p0[r];
#pragma unroll
    for (int r = 0; r < 16; ++r) ps += p1[r];
    { auto rr = __builtin_amdgcn_permlane32_swap(__float_as_uint(ps), __float_as_uint(ps), false, false); ps = __uint_as_float(rr[0]) + __uint_as_float(rr[1]); }
    l_reg = l_reg * alpha + ps;
#define PK4(P, B_, OUT) do { unsigned a0 = cvtpk(P[B_+0], P[B_+1]), a1 = cvtpk(P[B_+2], P[B_+3]);                          \
        unsigned b0 = cvtpk(P[B_+4], P[B_+5]), b1 = cvtpk(P[B_+6], P[B_+7]);                                             \
        auto r0 = __builtin_amdgcn_permlane32_swap(a0, b0, false, false); auto r1 = __builtin_amdgcn_permlane32_swap(a1, b1, false, false); \
        u32x4 w = {r0[0], r1[0], r0[1], r1[1]}; OUT = *reinterpret_cast<bf16x8*>(&w); } while (0)
    PK4(p0, 0, pa0); PK4(p0, 8, pa1); PK4(p1, 0, pa2); PK4(p1, 8, pa3);
#undef PK4
}
__device__ __forceinline__ void bias_init(f32x16& p0, f32x16& p1, const float* cb_t, int hi) {
    const float* cb = cb_t + 4 * hi;
    const f32x4 a0 = *(const f32x4*)(cb), a1 = *(const f32x4*)(cb + 8), a2 = *(const f32x4*)(cb + 16), a3 = *(const f32x4*)(cb + 24);
    const f32x4 b0 = *(const f32x4*)(cb + 32), b1 = *(const f32x4*)(cb + 40), b2 = *(const f32x4*)(cb + 48), b3 = *(const f32x4*)(cb + 56);
    p0 = (f32x16){a0[0], a0[1], a0[2], a0[3], a1[0], a1[1], a1[2], a1[3], a2[0], a2[1], a2[2], a2[3], a3[0], a3[1], a3[2], a3[3]};
    p1 = (f32x16){b0[0], b0[1], b0[2], b0[3], b1[0], b1[1], b1[2], b1[3], b2[0], b2[1], b2[2], b2[3], b3[0], b3[1], b3[2], b3[3]};
}
template <int KB>
__device__ __forceinline__ void qkt(f32x16& p0, f32x16& p1, const char* K_lds, int r32, int hi, const bf16x8* qr) {
    const char* kb[4];
#pragma unroll
    for (int dd = 0; dd < 4; ++dd) kb[dd] = K_lds + KB * SHM_K + KSWZ(r32, (dd * 16 + hi * 8) * 2);
#pragma unroll
    for (int d0 = 0; d0 < 8; ++d0) { const char* a = kb[d0 & 3] + (d0 >> 2) * 128;
        bf16x8 b0 = *reinterpret_cast<const bf16x8*>(a);
        bf16x8 b1 = *reinterpret_cast<const bf16x8*>(a + 32 * 256);
        p0 = __builtin_amdgcn_mfma_f32_32x32x16_bf16(b0, qr[d0], p0, 0, 0, 0);
        p1 = __builtin_amdgcn_mfma_f32_32x32x16_bf16(b1, qr[d0], p1, 0, 0, 0); }
}
__device__ __forceinline__ void pv_tile(f32x16* o, int vb0, bf16x8 pa0, bf16x8 pa1, bf16x8 pa2, bf16x8 pa3) {
#define TRRD(dst, off) asm volatile("ds_read_b64_tr_b16 %0, %1 offset:%2" : "=&v"(dst) : "v"(vb0), "i"(off) : "memory")
#define PV_D0(d0) do { s16x4 l0, l1, l2, l3, h0, h1, h2, h3; constexpr int b_ = v_rd_off(d0, 0, 0); \
        TRRD(l0, b_); TRRD(h0, b_ + 2048); TRRD(l1, b_ + 4096); TRRD(h1, b_ + 6144); TRRD(l2, b_ + 8192); TRRD(h2, b_ + 10240); TRRD(l3, b_ + 12288); TRRD(h3, b_ + 14336); \
        asm volatile("s_waitcnt lgkmcnt(0)" ::: "memory"); SBAR();   \
        o[d0] = __builtin_amdgcn_mfma_f32_32x32x16_bf16(pa0, (bf16x8){l0[0], l0[1], l0[2], l0[3], h0[0], h0[1], h0[2], h0[3]}, o[d0], 0, 0, 0);   \
        o[d0] = __builtin_amdgcn_mfma_f32_32x32x16_bf16(pa1, (bf16x8){l1[0], l1[1], l1[2], l1[3], h1[0], h1[1], h1[2], h1[3]}, o[d0], 0, 0, 0);   \
        o[d0] = __builtin_amdgcn_mfma_f32_32x32x16_bf16(pa2, (bf16x8){l2[0], l2[1], l2[2], l2[3], h2[0], h2[1], h2[2], h2[3]}, o[d0], 0, 0, 0);   \
        o[d0] = __builtin_amdgcn_mfma_f32_32x32x16_bf16(pa3, (bf16x8){l3[0], l3[1], l3[2], l3[3], h3[0], h3[1], h3[2], h3[3]}, o[d0], 0, 0, 0); } while (0)
    PV_D0(0); PV_D0(1); PV_D0(2); PV_D0(3);
#undef PV_D0
#undef TRRD
}
struct BlockRef { unsigned qoff, koff, ooff; int P0; int bh; };
struct Seam { bf16x8 qr[8]; bf16x8 st_v0, st_v1, st_k0, st_k1; int vg; };
#define GAS1 __attribute__((address_space(1)))
#define LDO(base, boff) (*(const GAS1 bf16x8*)((const GAS1 char*)(base) + (boff)))
#define VMW() asm volatile("s_waitcnt vmcnt(0)" ::: "memory")
#define VMWN(n) asm volatile("s_waitcnt vmcnt(%0)" :: "i"(n) : "memory")
#define OPQ(p) asm volatile("" : "+s"(p))
#define SLOAD_H(Kp, k0) do { const char* kt_ = (Kp) + (size_t)(k0) * (PQ * 2); OPQ(kt_); const char* vt_ = kt_ + SECB; OPQ(vt_); unsigned o0_ = so0, o1_ = so1; asm volatile("" : "+v"(o0_), "+v"(o1_));            \
                         S.st_v0 = LDO(vt_, o0_); S.st_v1 = LDO(vt_, o1_); S.st_k0 = LDO(kt_, o0_); S.st_k1 = LDO(kt_, o1_); } while (0)
#define SWRITE_HK(bf) do { *(bf16x8*)(K_lds + (bf) * SHM_K + kws) = S.st_k0; *(bf16x8*)(K_lds + (bf) * SHM_K + kws + 32 * 256) = S.st_k1; } while (0)
#define SWRITE_HV(vi_) do { *(bf16x8*)(V_lds + (vi_) * SHM_V + vst0) = S.st_v0; *(bf16x8*)(V_lds + (vi_) * SHM_V + vst1) = S.st_v1; } while (0)
#define SWRITE_H(kb_, vi_) do { SWRITE_HV(vi_); SWRITE_HK(kb_); } while (0)
__device__ __forceinline__ void prime(const BlockRef& cur, const char* QKVb, char* lds, Seam& S) {
    int tid_raw = threadIdx.x; asm volatile("" : "+v"(tid_raw));
    const int tid = tid_raw, wid = __builtin_amdgcn_readfirstlane(tid >> 6), lane = tid & 63, r32 = lane & 31, hi = lane >> 5;
    const int sr = tid >> 4, sc = (tid & 15) * 8, kws = KSWZ(sr, sc * 2); char* K_lds = lds + OFF_K;
    const unsigned so0 = (unsigned)(sr * PQ + sc) * 2u, so1 = so0 + 32u * PQ * 2u, qo = (unsigned)(r32 * PQ + hi * 8) * 2u;
    { const char* qb_ = QKVb + cur.qoff + (size_t)(wid * QBLK) * PQ * 2; OPQ(qb_); unsigned qo_ = qo; asm volatile("" : "+v"(qo_));
#pragma unroll
    for (int d0 = 0; d0 < 8; ++d0) S.qr[d0] = LDO(qb_, qo_ + d0 * 32); }
    S.vg = 0;
    { const char* Kh = QKVb + cur.koff; SLOAD_H(Kh, 0); } VMW(); SWRITE_HK(0);
    __syncthreads();
}
__device__ __forceinline__ void block(const BlockRef& cur, const BlockRef& nxt, const char* QKVb, char* OBb, char* lds, Seam& S) {
    int tid_raw = threadIdx.x; asm volatile("" : "+v"(tid_raw));
    const int tid = tid_raw, wid = __builtin_amdgcn_readfirstlane(tid >> 6), lane = tid & 63, r32 = lane & 31, hi = lane >> 5;
    const int NT = (cur.P0 + QB) / KVBLK;
    const int qlo = cur.P0 + wid * QBLK, qm = qlo + r32 - 4 * hi;
    char* V_lds = lds; char* K_lds = lds + OFF_K;
    float* ws = (float*)(lds + OFF_WS) + wid * 64; float* li_l = ws, * al_l = ws + 32; const float* cb_l = (const float*)(lds + OFF_CB);
    float m_reg = -1e30f, l_reg = 0; f32x16 o[4] = {};
    const int sr = tid >> 4, sc = (tid & 15) * 8, vst0 = v_st(sr, sc), vst1 = v_st(32 + sr, sc), kws = KSWZ(sr, sc * 2);
    const unsigned so0 = (unsigned)(sr * PQ + sc) * 2u, so1 = so0 + 32u * PQ * 2u, qo = (unsigned)(r32 * PQ + hi * 8) * 2u;
    const int vb0 = (int)(uintptr_t)V_lds + v_rd_base(lane);
    const char* Kh = QKVb + cur.koff;
#define RESC(a) do { if (__any((a) < 1.f)) { if (hi == 0) al_l[r32] = (a); asm volatile("s_waitcnt lgkmcnt(0)" ::: "memory");              \
                     for (int d_ = 0; d_ < 4; ++d_) for (int r = 0; r < 16; ++r) o[d_][r] *= al_l[crow(r, hi)]; } } while (0)
#define KBASE(t) ((t) * KVBLK)
#define MASKT(P0_, P1_, t) do { const int kb_ = KBASE(t); if (kb_ + KVBLK - 1 > qlo) mask_tile(P0_, P1_, qm - kb_); } while (0)
#define SEAM_K0() do { VMWN(8); SWRITE_HK(0); SBAR(); } while (0)
    f32x16 pA0, pA1, pB0, pB1; float mnA, mnB, alA, alB; bf16x8 pa0, pa1, pa2, pa3;
    int va = S.vg, vb_ = (va == 2) ? 0 : va + 1, vc = (vb_ == 2) ? 0 : vb_ + 1;
#define ROT3() do { va = vb_; vb_ = vc; vc = (vc == 2) ? 0 : vc + 1; } while (0)
    SWRITE_HV(va); SBAR();
    if (NT > 1) { SLOAD_H(Kh, KBASE(1)); }
    bias_init(pA0, pA1, cb_l, hi);
    SBAR(); qkt<0>(pA0, pA1, K_lds, r32, hi, S.qr);
    if (NT > 1) bias_init(pB0, pB1, cb_l + KBASE(1), hi);
    MASKT(pA0, pA1, 0); partialSM(pA0, pA1, m_reg, mnA, alA);
    if (NT > 1) { VMW(); SWRITE_H(1, vb_); }
    __syncthreads();
#define HALF_STEP(PX0, PX1, mnX, alX, PY0, PY1, alY, t, KB, VB, SB) do {                                                      \
        SBAR(); if ((t) + 1 < NT) { SLOAD_H(Kh, KBASE((t) + 1)); SBAR(); }         \
        qkt<KB>(PX0, PX1, K_lds, r32, hi, S.qr);                                                                              \
        finishSM(PY0, PY1, alY, l_reg, pa0, pa1, pa2, pa3); SBAR();                                                           \
        if ((t) + 1 < NT) bias_init(PY0, PY1, cb_l + KBASE((t) + 1), hi);     \
        pv_tile(o, vb0 + va * SHM_V, pa0, pa1, pa2, pa3); MASKT(PX0, PX1, (t)); partialSM(PX0, PX1, m_reg, mnX, alX);          \
        if ((t) + 1 < NT) { VMW(); SWRITE_H(SB, vc); }       \
        RESC(alX); __syncthreads(); ROT3(); } while (0)
    for (int t = 1; t + 1 < NT; t += 2) {
        HALF_STEP(pB0, pB1, mnB, alB, pA0, pA1, alA, t, 1, 0, 0);
        HALF_STEP(pA0, pA1, mnA, alA, pB0, pB1, alB, t + 1, 0, 1, 1);
    }
    const bool even = (NT & 1) == 0;
    if (even) { SBAR(); qkt<1>(pB0, pB1, K_lds, r32, hi, S.qr); SBAR(); }
    { const char* Kn = QKVb + nxt.koff; SLOAD_H(Kn, 0); } SBAR();
    { const char* qb_ = QKVb + nxt.qoff + (size_t)(wid * QBLK) * PQ * 2; OPQ(qb_); unsigned qo_ = qo; asm volatile("" : "+v"(qo_));
#pragma unroll
    for (int d0 = 0; d0 < 8; ++d0) S.qr[d0] = LDO(qb_, qo_ + d0 * 32); }
    SBAR();
    finishSM(pA0, pA1, alA, l_reg, pa0, pa1, pa2, pa3); SBAR();
    pv_tile(o, vb0 + va * SHM_V, pa0, pa1, pa2, pa3);
    if (even) { MASKT(pB0, pB1, NT - 1); partialSM(pB0, pB1, m_reg, mnB, alB); __syncthreads(); RESC(alB);
        finishSM(pB0, pB1, alB, l_reg, pa0, pa1, pa2, pa3); SBAR(); pv_tile(o, vb0 + vb_ * SHM_V, pa0, pa1, pa2, pa3); }
    S.vg = even ? vc : vb_;
    SBAR(); SEAM_K0();
    if (hi == 0) li_l[r32] = l_reg; asm volatile("s_waitcnt lgkmcnt(0)" ::: "memory");
    float rli[16];
#pragma unroll
    for (int r = 0; r < 16; ++r) rli[r] = __builtin_amdgcn_rcpf(li_l[crow(r, hi)]);
    char* Ow = OBb + cur.ooff + (size_t)(wid * QBLK) * PO * 2; OPQ(Ow); unsigned oo = (unsigned)(4 * hi * PO + r32) * 2u; asm volatile("" : "+v"(oo));
#pragma unroll
    for (int r = 0; r < 16; ++r) { const unsigned orb = (unsigned)(((r & 3) + 8 * (r >> 2)) * PO) * 2u;
#pragma unroll
        for (int d0 = 0; d0 < 4; ++d0) { const float v = o[d0][r] * rli[r]; const float vn = __uint_as_float(__builtin_amdgcn_mov_dpp(__float_as_uint(v), 0xB1, 0xf, 0xf, true));
            if ((r32 & 1) == 0) *(GAS1 unsigned*)((GAS1 char*)Ow + (oo + orb + d0 * 64)) = cvtpk(v, vn); } }
    __syncthreads();
#undef RESC
#undef KBASE
#undef MASKT
#undef SEAM_K0
#undef HALF_STEP
#undef ROT3
}
#undef LDO
#undef GAS1
#undef OPQ
#undef VMW
#undef VMWN
#undef SLOAD_H
#undef SWRITE_HK
#undef SWRITE_HV
#undef SWRITE_H
__device__ __forceinline__ BlockRef make_ref(int L, int pass) {
    const int xcd = L & 7, k = L >> 3, bh = (k >> 4) * 8 + xcd, x = k & 15, qb = pass ? 31 - x : x, b = bh >> 4, h = bh & 15;
    BlockRef r; r.P0 = qb * QB; r.bh = bh;
    r.qoff = (unsigned)(((bh * SEQ + r.P0) * PQ) * 2); r.koff = (unsigned)(SECB + (size_t)(bh * SEQ) * PQ * 2); r.ooff = (unsigned)(((b * SEQ + r.P0) * PO + h * D) * 2);
    return r;
}
__device__ __forceinline__ void attn_phase(char* lds, const bf16* QKV, bf16* OB, const float* LP, const float* TT) {
    const int total = 512; int stride = gridDim.x, L = blockIdx.x; asm volatile("" : "+s"(stride), "+s"(L)); if (L >= total) return;
    { int w_ = threadIdx.x >> 6; asm volatile("" : "+v"(w_)); if (__builtin_amdgcn_readfirstlane(w_) < 4) __builtin_amdgcn_s_setprio(2); else __builtin_amdgcn_s_setprio(0); }
    int pass = 0; BlockRef cur = make_ref(L, 0); Seam S; int bh_lds = -1; const char* QKVb = (const char*)QKV; char* OBb = (char*)OB;
    prime(cur, QKVb, lds, S);
    for (;;) {
        if (cur.bh != bh_lds) {
            int t0_ = threadIdx.x; asm volatile("" : "+v"(t0_)); const int b_ = cur.bh >> 4, h_ = cur.bh & 15, ln_ = t0_ & 63, wv_ = t0_ >> 6;
            float* wt_ = (float*)(lds + OFF_WS); float* dst = (float*)(lds + OFF_CB);
            const float tt_ = TT[(size_t)(b_ * 512 + t0_) * 16 + h_]; float inc_ = tt_;
#pragma unroll
            for (int o_ = 1; o_ < 64; o_ <<= 1) { const float u_ = __shfl_up(inc_, o_); if (ln_ >= o_) inc_ += u_; }
            if (ln_ == 63) wt_[wv_] = inc_;
            __syncthreads();
            float off_ = inc_ - tt_; for (int w_ = 0; w_ < wv_; ++w_) off_ += wt_[w_];
            const float* lp_ = LP + ((size_t)b_ * SEQ + (size_t)t0_ * 16) * 16 + h_;
#pragma unroll
            for (int i = 0; i < 16; i += 4) { f32x4 v_ = {lp_[(i + 0) * 16], lp_[(i + 1) * 16], lp_[(i + 2) * 16], lp_[(i + 3) * 16]}; *(f32x4*)(dst + t0_ * 16 + i) = (v_ + off_) * (-LOG2E); }
            bh_lds = cur.bh; __syncthreads(); }
        const bool more_pass = pass == 0, more_item = L + stride < total, last = !more_pass && !more_item;
        int passn = pass + 1, Ln = L; if (!more_pass) { passn = 0; Ln = more_item ? L + stride : L; }
        const BlockRef nxt = last ? cur : make_ref(Ln, passn);
        block(cur, nxt, QKVb, OBb, lds, S);
        if (last) break;
        cur = nxt; pass = passn; L = Ln;
    }
    __builtin_amdgcn_s_setprio(0);
}
#undef SBAR
#undef KSWZ
}
#define LAS __attribute__((address_space(3)))
typedef unsigned short bf16;
typedef unsigned v4u __attribute__((ext_vector_type(4)));
typedef unsigned v2u __attribute__((ext_vector_type(2)));
typedef float f32x4 __attribute__((ext_vector_type(4)));
typedef short bf16x8 __attribute__((ext_vector_type(8)));
constexpr int NWAVES = 8;
constexpr int M = 16384, DM = 2048, SEQ = 8192, NH = 16, HD = 128, FF = 8192, NQKV = 6144, NFOXW = 6160, NUV = 4096;
#ifndef NDEPTH
#define NDEPTH 4
#endif
constexpr int DEPTH = NDEPTH;
constexpr float EPS = 1e-6f;
constexpr size_t MiB = 1u << 20;
constexpr size_t WS_CTL = 0, WS_LF = 1 * MiB, WS_C = 2 * MiB, WS_XB = 4 * MiB, WS_FWIN = 68 * MiB, WS_FWOUT = 117 * MiB, WS_SWIN = 133 * MiB, WS_SWOUT = 165 * MiB,
                 WS_W1 = 181 * MiB, WS_W2 = 309 * MiB, WS_BIG = 437 * MiB, WS_SSQ = 693 * MiB, WS_END = 698 * MiB;
constexpr size_t FWIN_STRIDE = (size_t)NFOXW * DM;
constexpr int LDS_BYTES = 147456, LDS_X = 131072, LDS_MISC = 131072 + 8192;
static_assert(att::LDS_BYTES <= 131072 && pg8::STAGE_BYTES == 131072, "LDS map");

__device__ __forceinline__ unsigned pk2(float lo, float hi) { unsigned r; asm volatile("v_cvt_pk_bf16_f32 %0, %1, %2" : "=v"(r) : "v"(lo), "v"(hi)); return r; }
__device__ __forceinline__ float bf_lo(unsigned w) { return __uint_as_float(w << 16); }
__device__ __forceinline__ float bf_hi(unsigned w) { return __uint_as_float(w & 0xffff0000u); }
__device__ __forceinline__ float wave_sum(float v) {
#pragma unroll
    for (int o = 1; o < 64; o <<= 1) v += __shfl_xor(v, o);
    return v;
}
#define LDS_WAIT() asm volatile("s_waitcnt lgkmcnt(0)" ::: "memory")
__device__ __forceinline__ void p0_transpose_item(const float* W, int K, int N, const float* gain, bf16* WT, LAS float* scr, int item, int lane) {
    const int nblk = (N + 63) / 64, kb = item / nblk, nb = item % nblk, k0 = 64 * kb, n0 = 64 * nb;
    const int nl = lane & 15, kr = lane >> 4, nn = n0 + 4 * nl; const bool nok = nn < N;
    f32x4 v[16];
#pragma unroll
    for (int i = 0; i < 16; ++i) v[i] = nok ? *(const f32x4*)(W + (size_t)(k0 + 4 * i + kr) * N + nn) : (f32x4){0.f, 0.f, 0.f, 0.f};
#pragma unroll
    for (int i = 0; i < 16; ++i) { const int kk = 4 * i + kr; const float g = gain ? gain[k0 + kk] : 1.f; LAS float* d = scr + kk * 65 + 4 * nl;
        d[0] = v[i][0] * g; d[1] = v[i][1] * g; d[2] = v[i][2] * g; d[3] = v[i][3] * g; }
    LDS_WAIT(); asm volatile("" ::: "memory");
    const int c = lane & 7;
#pragma unroll
    for (int j = 0; j < 8; ++j) { const int n = (lane >> 3) + 8 * j; const LAS float* s = scr + (8 * c) * 65 + n;
        v4u o; o.x = pk2(s[0 * 65], s[1 * 65]); o.y = pk2(s[2 * 65], s[3 * 65]); o.z = pk2(s[4 * 65], s[5 * 65]); o.w = pk2(s[6 * 65], s[7 * 65]);
        if (n0 + n < N) *(v4u*)(WT + (size_t)(n0 + n) * K + k0 + 8 * c) = o; }
    LDS_WAIT(); asm volatile("" ::: "memory");
}
#define XB_TMO      128
#define XB_XCNT(j)  (256  + 64 * (j))
#define XB_XSUB(j)  (1280 + 64 * (j))
#define XB_XGEN(j)  (2304 + 64 * (j))
#define XB_TOP      3328
#define XB_TOPGEN   3392
#define XCD_BAR_WORDS 3456
#define XB_SPIN_CAP (1u << 18)

__device__ __forceinline__ unsigned xb_ld(unsigned* p)              { return __hip_atomic_load(p, __ATOMIC_RELAXED, __HIP_MEMORY_SCOPE_AGENT); }
__device__ __forceinline__ unsigned xb_add(unsigned* p, unsigned v) { return __hip_atomic_fetch_add(p, v, __ATOMIC_RELAXED, __HIP_MEMORY_SCOPE_AGENT); }
__device__ __forceinline__ unsigned xb_xcc_id() { return (unsigned)__builtin_amdgcn_s_getreg((3 << 11) | 20) & 0xFu; }
#define XB_SPIN(cond, bar) do { unsigned _sp = 0; while (cond) { __builtin_amdgcn_s_sleep(1); \
    if ((++_sp & 255u) == 0u) { if (xb_ld(&(bar)[XB_TMO])) break; if (_sp > XB_SPIN_CAP) { atomicAdd(&(bar)[XB_TMO], 1u); break; } } } } while (0)

struct XcdBarrier {
    unsigned* bar; unsigned x;
    volatile LAS unsigned* st;
};

__device__ __forceinline__ XcdBarrier xcd_barrier_post(unsigned* bar, volatile LAS unsigned* st) {
    XcdBarrier b; b.bar = bar; b.x = xb_xcc_id(); b.st = st;
    if (threadIdx.x == 0) (void)xb_add(&bar[XB_XCNT(b.x)], 1u);
    return b;
}
__device__ __forceinline__ void xcd_barrier_complete(unsigned* bar, unsigned x, unsigned& nloc, unsigned& nx) {
    const unsigned G = gridDim.x * gridDim.y * gridDim.z;
    unsigned sum, cnt, mine, sp = 0u;
    for (;;) {
        sum = 0u; cnt = 0u; mine = 0u;
#pragma unroll
        for (unsigned j = 0; j < 16; ++j) { const unsigned c = xb_ld(&bar[XB_XCNT(j)]); sum += c; cnt += (c > 0u) ? 1u : 0u; mine = (j == x) ? c : mine; }
        if (sum == G) break;
        __builtin_amdgcn_s_sleep(1);
        if ((++sp & 255u) == 0u) { if (xb_ld(&bar[XB_TMO])) break; if (sp > XB_SPIN_CAP) { atomicAdd(&bar[XB_TMO], 1u); break; } }
    }
    nloc = mine > 0u ? mine : 1u; nx = cnt > 0u ? cnt : 1u;
}

__device__ __forceinline__ void xcd_barrier(const XcdBarrier& b) {
    asm volatile("s_waitcnt vmcnt(0)" ::: "memory");
    __syncthreads();
    if (threadIdx.x == 0) {
        unsigned* bar = b.bar;
        __builtin_amdgcn_s_waitcnt(0);
        unsigned nloc = b.st[0], nx = b.st[1];
        if (nloc == 0u) { xcd_barrier_complete(bar, b.x, nloc, nx); b.st[0] = nloc; b.st[1] = nx; }
        const unsigned old = xb_add(&bar[XB_XSUB(b.x)], 1u);
        const unsigned gen = old / nloc;
        if (old + 1u == (gen + 1u) * nloc) {
            __builtin_amdgcn_fence(__ATOMIC_RELEASE, "agent");
            asm volatile("s_waitcnt vmcnt(0)" ::: "memory");
            const unsigned og = xb_add(&bar[XB_TOP], 1u);
            const unsigned tg = og / nx;
            if (og + 1u == (tg + 1u) * nx) xb_add(&bar[XB_TOPGEN], 1u);
            else XB_SPIN(xb_ld(&bar[XB_TOPGEN]) == tg, bar);
            __builtin_amdgcn_fence(__ATOMIC_ACQUIRE, "agent");
            xb_add(&bar[XB_XGEN(b.x)], 1u);
            asm volatile("s_waitcnt vmcnt(0)" ::: "memory");
        } else {
            XB_SPIN(xb_ld(&bar[XB_XGEN(b.x)]) == gen, bar);
            __builtin_amdgcn_fence(__ATOMIC_ACQUIRE, "agent");
            asm volatile("s_waitcnt vmcnt(0)" ::: "memory");
        }
    }
    __syncthreads();
}

struct Args {
    const float* x; const float* g_mix; const float* g_mlp; const float* fox_w_in; const float* fox_b_f; const float* fox_g_q; const float* fox_g_k; const float* fox_w_out;
    const float* sgu_w_in; const float* sgu_b_in; const float* sgu_g_v; const float* sgu_w_s; const float* sgu_b_s; const float* sgu_w_out; const float* mlp_w1; const float* mlp_w2;
    float* out; unsigned char* ws;
};

__global__ void __launch_bounds__(NWAVES * 64, 2) fwd_megakernel(Args a_unused) {
    extern __shared__ __attribute__((aligned(16))) unsigned char lds[];
    cg::grid_group grid = cg::this_grid();
    LAS unsigned char* ldsl = (LAS unsigned char*)lds;
#ifdef DBG_FENCE
#define GRID_SYNC() do { __threadfence(); grid.sync(); __threadfence(); } while (0)
#else
#define GRID_SYNC() do { asm volatile("s_waitcnt vmcnt(0)" ::: "memory"); grid.sync(); } while (0)
#endif
#define XSYNC() do { FRESH(kx_); XcdBarrier xb_; xb_.bar = (unsigned*)(kx_->ws + WS_CTL); xb_.x = xb_xcc_id(); xb_.st = (volatile LAS unsigned*)(ldsl + LDS_MISC); xcd_barrier(xb_); } while (0)
#define IDS() int tid = threadIdx.x, G = gridDim.x, bx = blockIdx.x; asm volatile("" : "+v"(tid), "+s"(G), "+s"(bx)); \
              const int lane = tid & 63, wave = __builtin_amdgcn_readfirstlane(tid >> 6), gw = bx * NWAVES + wave, NGW = G * NWAVES; (void)lane; (void)gw; (void)NGW
    typedef const __attribute__((address_space(4))) Args* KAp;
#define FRESH(ka) KAp ka = (KAp)__builtin_amdgcn_kernarg_segment_ptr(); asm volatile("" : "+s"(ka))
#define P_SSQ(ka) ((float*)((ka)->ws + WS_SSQ))
#define P_LF(ka) ((float*)((ka)->ws + WS_LF))
#define P_CUM(ka) ((float*)((ka)->ws + WS_C))
#define P_XB(ka) ((bf16*)((ka)->ws + WS_XB))
#define P_FWIN(ka) ((bf16*)((ka)->ws + WS_FWIN))
#define P_FWOUT(ka) ((bf16*)((ka)->ws + WS_FWOUT))
#define P_SWIN(ka) ((bf16*)((ka)->ws + WS_SWIN))
#define P_SWOUT(ka) ((bf16*)((ka)->ws + WS_SWOUT))
#define P_W1T(ka) ((bf16*)((ka)->ws + WS_W1))
#define P_W2T(ka) ((bf16*)((ka)->ws + WS_W2))
#define P_BIG(ka) ((bf16*)((ka)->ws + WS_BIG))
#define P_QKV(ka) P_BIG(ka)
#define P_OB(ka) (P_BIG(ka) + (size_t)M * NQKV)
#define P_UV(ka) P_BIG(ka)
#define P_GB(ka) (P_BIG(ka) + (size_t)M * NUV)
#define P_HB(ka) P_BIG(ka)

    { FRESH(a0_); if (threadIdx.x < 2) ((volatile LAS unsigned*)(ldsl + LDS_MISC))[threadIdx.x] = 0u;
      if (blockIdx.x == 0) { unsigned* cw = (unsigned*)(a0_->ws + WS_CTL); for (int i = threadIdx.x; i < XCD_BAR_WORDS; i += NWAVES * 64) cw[i] = 0u; }
      __syncthreads(); }
#ifdef DBG_LDSZERO
    { for (int i = threadIdx.x; i < LDS_BYTES / 16; i += NWAVES * 64) ((LAS v4u*)ldsl)[i] = (v4u){0u, 0u, 0u, 0u}; __syncthreads(); }
#endif
#ifndef REP_PRO
#define REP_PRO 1
#endif
    for (int rep_ = 0; rep_ < REP_PRO; ++rep_) {
        FRESH(a_); IDS();
        float* ssq = P_SSQ(a_); bf16* XB = P_XB(a_);
        bf16* FWIN = P_FWIN(a_); bf16* FWOUT = P_FWOUT(a_); bf16* SWIN = P_SWIN(a_); bf16* SWOUT = P_SWOUT(a_); bf16* W1T = P_W1T(a_); bf16* W2T = P_W2T(a_);
        LAS float* scr = (LAS float*)(ldsl + wave * 16640);
        constexpr int I_FWIN = (DM / 64) * ((NFOXW + 63) / 64), I_SQ = (DM / 64) * (DM / 64), I_SWIN = (DM / 64) * (NUV / 64), I_W1 = (DM / 64) * (FF / 64), I_W2 = (FF / 64) * (DM / 64);
        constexpr int NITEMS = 2 * I_FWIN + 2 * I_SQ + 2 * I_SWIN + 2 * I_SQ + 4 * I_W1 + 4 * I_W2;
        for (int it = gw; it < NITEMS; it += NGW) {
            int r = NITEMS - 1 - it;
            if (r < 2 * I_FWIN) { const int j = r / I_FWIN; r -= j * I_FWIN; p0_transpose_item(a_->fox_w_in + (size_t)j * DM * NFOXW, DM, NFOXW, a_->g_mix + (size_t)(2 * j) * DM, FWIN + (size_t)j * FWIN_STRIDE, scr, r, lane); continue; } r -= 2 * I_FWIN;
            if (r < 2 * I_SQ) { const int j = r / I_SQ; r -= j * I_SQ; p0_transpose_item(a_->fox_w_out + (size_t)j * DM * DM, DM, DM, nullptr, FWOUT + (size_t)j * DM * DM, scr, r, lane); continue; } r -= 2 * I_SQ;
            if (r < 2 * I_SWIN) { const int j = r / I_SWIN; r -= j * I_SWIN; p0_transpose_item(a_->sgu_w_in + (size_t)j * DM * NUV, DM, NUV, a_->g_mix + (size_t)(2 * j + 1) * DM, SWIN + (size_t)j * DM * NUV, scr, r, lane); continue; } r -= 2 * I_SWIN;
            if (r < 2 * I_SQ) { const int j = r / I_SQ; r -= j * I_SQ; p0_transpose_item(a_->sgu_w_out + (size_t)j * DM * DM, DM, DM, nullptr, SWOUT + (size_t)j * DM * DM, scr, r, lane); continue; } r -= 2 * I_SQ;
            if (r < 4 * I_W1) { const int j = r / I_W1; r -= j * I_W1; p0_transpose_item(a_->mlp_w1 + (size_t)j * DM * FF, DM, FF, a_->g_mlp + (size_t)j * DM, W1T + (size_t)j * DM * FF, scr, r, lane); continue; } r -= 4 * I_W1;
            { const int j = r / I_W2; r -= j * I_W2; p0_transpose_item(a_->mlp_w2 + (size_t)j * DM * FF, FF, DM, nullptr, W2T + (size_t)j * DM * FF, scr, r, lane); }
        }
        for (int m = gw; m < M; m += NGW) {
            const f32x4* xr = (const f32x4*)(a_->x + (size_t)m * DM) + lane; v2u* o8 = (v2u*)(XB + (size_t)m * DM) + lane; float s = 0.f;
#pragma unroll
            for (int j = 0; j < 8; ++j) { const f32x4 v = xr[64 * j]; s += (v[0] * v[0] + v[1] * v[1]) + (v[2] * v[2] + v[3] * v[3]); v2u w; w.x = pk2(v[0], v[1]); w.y = pk2(v[2], v[3]); o8[64 * j] = w; }
            s = wave_sum(s); if (lane == 0) { *(f32x4*)(ssq + (size_t)m * 8) = (f32x4){s, 0.f, 0.f, 0.f}; *(f32x4*)(ssq + (size_t)m * 8 + 4) = (f32x4){0.f, 0.f, 0.f, 0.f}; }
        }
    }
    GRID_SYNC();
    { FRESH(a1_); (void)xcd_barrier_post((unsigned*)(a1_->ws + WS_CTL), (volatile LAS unsigned*)(ldsl + LDS_MISC)); }
#ifndef WGM_G1F
#define WGM_G1F 4
#endif
#ifndef WGM_G1S
#define WGM_G1S 4
#endif
#ifndef WGM_G2
#define WGM_G2 4
#endif
#ifndef WGM_G3
#define WGM_G3 4
#endif
#ifndef WGM_G4
#define WGM_G4 4
#endif
    for (int layer = 0; layer < DEPTH; ++layer) {
        const int j = layer >> 1;
#define SSQ_MIX(ka) (P_SSQ(ka) + (size_t)(2 * layer) * M * 8)
#define SSQ_MLP(ka) (P_SSQ(ka) + (size_t)(2 * layer + 1) * M * 8)
#define SSQ_NXT(ka) (P_SSQ(ka) + (size_t)(2 * layer + 2) * M * 8)
        if ((layer & 1) == 0) {
#ifndef NO_GATE
#ifndef REP_GATE
#define REP_GATE 1
#endif
            for (int rep_ = 0; rep_ < REP_GATE; ++rep_) { FRESH(a); IDS(); const bf16* Win = P_FWIN(a) + (size_t)j * FWIN_STRIDE; const bf16* XB = P_XB(a); const float* ssq_mix = SSQ_MIX(a); float* LF = P_LF(a); const float* bfp = a->fox_b_f + j * NH;
            for (int task = gw; task < M / 16; task += NGW) {
                const int fr = lane & 15, kq = lane >> 4;
                const bf16* ap = Win + (size_t)(NQKV + fr) * DM + 8 * kq;
                const bf16* bp = XB + (size_t)(task * 16 + fr) * DM + 8 * kq;
                f32x4 acc = {0.f, 0.f, 0.f, 0.f};
#pragma unroll 8
                for (int kk = 0; kk < DM / 32; ++kk) acc = __builtin_amdgcn_mfma_f32_16x16x32_bf16(*(const bf16x8*)(ap + 32 * kk), *(const bf16x8*)(bp + 32 * kk), acc, 0, 0, 0);
                const int row = task * 16 + fr; const float rs = pg8::rstd_row(ssq_mix, row); f32x4 o;
#pragma unroll
                for (int e = 0; e < 4; ++e) { const float z = acc[e] * rs + bfp[4 * kq + e]; o[e] = fminf(z, 0.f) - log1pf(expf(-fabsf(z))); }
#pragma unroll
                for (int d = 1; d < 16; d <<= 1) { f32x4 t_; t_[0] = __shfl_up(o[0], d, 16); t_[1] = __shfl_up(o[1], d, 16); t_[2] = __shfl_up(o[2], d, 16); t_[3] = __shfl_up(o[3], d, 16); if (fr >= d) o += t_; }
                *(f32x4*)(LF + (size_t)row * 16 + 4 * kq) = o;
                if (fr == 15) *(f32x4*)(P_CUM(a) + (size_t)task * 16 + 4 * kq) = o;
            } }
#endif
#ifndef NO_G1F
#ifndef REP_G1F
#define REP_G1F 1
#endif
            for (int rep_ = 0; rep_ < REP_G1F; ++rep_) {
                FRESH(a); IDS(); pg8::Gemm g{P_XB(a), P_FWIN(a) + (size_t)j * FWIN_STRIDE, M, NQKV, DM}; pg8::StaticOrder S; S.init(M, NQKV, G, bx, WGM_G1F);
                #ifndef PROBE_QKVMODE
#define PROBE_QKVMODE 0
#endif
                pg8::EpiQKV E{P_QKV(a), SSQ_MIX(a), a->fox_g_q + j * HD, a->fox_g_k + j * HD, (LAS float*)(ldsl + LDS_X), (REP_G1F > 1 && rep_ == 0) ? PROBE_QKVMODE : 0};
                pg8::gemm_phase<pg8::EpiQKV, pg8::StaticOrder, true, true>(ldsl, g, S, E);
            }
#endif
            XSYNC();
#ifndef NO_ATT
#ifndef REP_ATT
#define REP_ATT 1
#endif
            for (int rep_ = 0; rep_ < REP_ATT; ++rep_) { FRESH(a); att::attn_phase((char*)lds, P_QKV(a), P_OB(a), P_LF(a), P_CUM(a)); }
#endif
            XSYNC();
        } else {
#ifndef NO_G1S
#ifndef REP_G1S
#define REP_G1S 1
#endif
            for (int rep_ = 0; rep_ < REP_G1S; ++rep_) {
                FRESH(a); IDS(); pg8::Gemm g{P_XB(a), P_SWIN(a) + (size_t)j * DM * NUV, M, NUV, DM}; pg8::StaticOrder S; S.init(M, NUV, G, bx, WGM_G1S);
                pg8::EpiAct<2> E{P_UV(a), NUV, a->sgu_b_in + (size_t)j * NUV, SSQ_MIX(a), 0};
                pg8::gemm_phase<pg8::EpiAct<2>, pg8::StaticOrder, true, true>(ldsl, g, S, E);
            }
#endif
            XSYNC();
#ifndef NO_SG
#ifndef REP_SG
#define REP_SG 1
#endif
            for (int rep_ = 0; rep_ < REP_SG; ++rep_) {
                FRESH(a); IDS(); const bf16* UV = P_UV(a); bf16* GB = P_GB(a); const float* g_v = a->sgu_g_v; const float* w_s = a->sgu_w_s; const float* b_s = a->sgu_b_s;
                LAS bf16* VT = (LAS bf16*)ldsl; constexpr int VP = 136;
                for (int unit = bx; unit < (M / 128) * 16; unit += G) {
                    const int ch = unit >> 4, gI = unit & 15;
                    {   const int s = tid >> 2, q4 = tid & 3;
                        const v4u* vp = (const v4u*)(UV + (size_t)(ch * 128 + s) * NUV + 2048 + gI * 128 + q4 * 32);
                        float f[32]; float ss = 0.f;
#pragma unroll
                        for (int c = 0; c < 4; ++c) { const v4u w = vp[c]; f[8 * c + 0] = bf_lo(w.x); f[8 * c + 1] = bf_hi(w.x); f[8 * c + 2] = bf_lo(w.y); f[8 * c + 3] = bf_hi(w.y);
                            f[8 * c + 4] = bf_lo(w.z); f[8 * c + 5] = bf_hi(w.z); f[8 * c + 6] = bf_lo(w.w); f[8 * c + 7] = bf_hi(w.w); }
#pragma unroll
                        for (int e = 0; e < 32; ++e) ss += f[e] * f[e];
                        ss += __shfl_xor(ss, 1); ss += __shfl_xor(ss, 2);
                        const float rv = __builtin_amdgcn_rsqf(ss * (1.0f / 128.0f) + EPS);
                        const float* gv = g_v + (size_t)j * DM + gI * 128 + q4 * 32;
#pragma unroll
                        for (int e = 0; e < 32; e += 2) { const unsigned w = pk2(f[e] * rv * gv[e], f[e + 1] * rv * gv[e + 1]);
                            VT[(q4 * 32 + e) * VP + s] = (bf16)(w & 0xffffu); VT[(q4 * 32 + e + 1) * VP + s] = (bf16)(w >> 16); }
                    }
                    __syncthreads();
                    {   const int fr = lane & 15, kq = lane >> 4, t = 16 * wave + fr, kmax = (16 * wave + 15) >> 5;
                        const float* wsrow = w_s + (((size_t)j * 16 + gI) * 128 + t) * 128;
                        bf16x8 bw[4];
#pragma unroll
                        for (int ks = 0; ks < 4; ++ks) { v4u w = {0u, 0u, 0u, 0u};
                            if (ks <= kmax) { const int s0 = 32 * ks + 8 * kq; const f32x4 lo = *(const f32x4*)(wsrow + s0), hi4 = *(const f32x4*)(wsrow + s0 + 4);
                                float e[8] = {lo[0], lo[1], lo[2], lo[3], hi4[0], hi4[1], hi4[2], hi4[3]};
#pragma unroll
                                for (int i = 0; i < 8; ++i) if (s0 + i > t) e[i] = 0.f;
                                w.x = pk2(e[0], e[1]); w.y = pk2(e[2], e[3]); w.z = pk2(e[4], e[5]); w.w = pk2(e[6], e[7]); }
                            bw[ks] = __builtin_bit_cast(bf16x8, w); }
                        const float bs = b_s[((size_t)j * 16 + gI) * 128 + t];
                        const size_t row = (size_t)ch * 128 + t;
                        v2u uws[8];
#pragma unroll
                        for (int nt = 0; nt < 8; ++nt) uws[nt] = *(const v2u*)(UV + row * NUV + gI * 128 + 16 * nt + 4 * kq);
#pragma unroll
                        for (int nt = 0; nt < 8; ++nt) { f32x4 acc = {0.f, 0.f, 0.f, 0.f};
#pragma unroll
                            for (int ks = 0; ks < 4; ++ks) if (ks <= kmax) { const bf16x8 av = *(const LAS bf16x8*)(VT + (16 * nt + fr) * VP + 32 * ks + 8 * kq);
                                acc = __builtin_amdgcn_mfma_f32_16x16x32_bf16(av, bw[ks], acc, 0, 0, 0); }
                            const int col = gI * 128 + 16 * nt + 4 * kq;
                            const v2u uw = uws[nt];
                            v2u o; o.x = pk2(bf_lo(uw.x) * (acc[0] + bs), bf_hi(uw.x) * (acc[1] + bs)); o.y = pk2(bf_lo(uw.y) * (acc[2] + bs), bf_hi(uw.y) * (acc[3] + bs));
                            *(v2u*)(GB + row * DM + col) = o; }
                    }
                    __syncthreads();
                }
            }
#endif
            XSYNC();
        }
#ifndef NO_G2
        {
            FRESH(a); IDS(); const bool fox = (layer & 1) == 0;
            const bf16* Amix = fox ? P_OB(a) : P_GB(a); const bf16* Wmix = (fox ? P_FWOUT(a) : P_SWOUT(a)) + (size_t)j * DM * DM;
            pg8::Gemm g{Amix, Wmix, M, DM, DM}; pg8::StaticOrder S; S.init(M, DM, G, bx, WGM_G2);
            pg8::EpiResid E{(layer == 0) ? a->x : (const float*)nullptr, (float*)nullptr, P_XB(a), SSQ_MLP(a), (LAS float*)(ldsl + LDS_X), (const float*)nullptr};
            pg8::gemm_phase<pg8::EpiResid, pg8::StaticOrder, true, true>(ldsl, g, S, E);
        }
#endif
        XSYNC();
#ifndef NO_G3
#ifndef REP_G3
#define REP_G3 1
#endif
#ifndef PROBE_NOSTORE
#define PROBE_NOSTORE 0
#endif
        for (int rep_ = 0; rep_ < REP_G3; ++rep_) {
            FRESH(a); IDS(); pg8::Gemm g{P_XB(a), P_W1T(a) + (size_t)layer * DM * FF, M, FF, DM}; pg8::StaticOrder S; S.init(M, FF, G, bx, WGM_G3);
            pg8::EpiAct<1> E{P_HB(a), FF, nullptr, SSQ_MLP(a), (REP_G3 > 1 && rep_ == 0 && PROBE_NOSTORE) ? 1 : 0};
            pg8::gemm_phase<pg8::EpiAct<1>, pg8::StaticOrder, true, true>(ldsl, g, S, E);
        }
#endif
        XSYNC();
#ifdef PROBE_G4D
        for (int rep_ = 0; rep_ < PROBE_G4D; ++rep_) {
            FRESH(a); IDS(); pg8::Gemm g{P_HB(a), P_W2T(a) + (size_t)layer * DM * FF, M, DM, FF}; pg8::StaticOrder S; S.init(M, DM, G, bx);
            pg8::EpiAct<1> E{P_HB(a), FF, nullptr, SSQ_MLP(a), 1};
            pg8::gemm_phase<pg8::EpiAct<1>, pg8::StaticOrder, true, true>(ldsl, g, S, E);
        }
#endif
#ifdef PROBE_G4R
        for (int rep_ = 0; rep_ < PROBE_G4R; ++rep_) {
            FRESH(a); IDS(); pg8::Gemm g{P_HB(a), P_W2T(a) + (size_t)layer * DM * FF, M, DM, FF}; pg8::StaticOrder S; S.init(M, DM, G, bx);
            pg8::EpiResid E{(const float*)nullptr, (float*)nullptr, (bf16*)(a->ws + 700 * MiB), (float*)(a->ws + 770 * MiB), (LAS float*)(ldsl + LDS_X), (const float*)SSQ_MLP(a)};
            pg8::gemm_phase<pg8::EpiResid, pg8::StaticOrder, true, true>(ldsl, g, S, E);
        }
#endif
#ifdef PROBE_G2R
        for (int rep_ = 0; rep_ < PROBE_G2R; ++rep_) {
            FRESH(a); IDS(); pg8::Gemm g{P_XB(a), P_FWOUT(a), M, DM, DM}; pg8::StaticOrder S; S.init(M, DM, G, bx);
            pg8::EpiResid E{(const float*)nullptr, (float*)nullptr, (bf16*)(a->ws + 700 * MiB), (float*)(a->ws + 770 * MiB), (LAS float*)(ldsl + LDS_X), (const float*)nullptr};
            pg8::gemm_phase<pg8::EpiResid, pg8::StaticOrder, true, true>(ldsl, g, S, E);
        }
#endif
#ifndef NO_G4
        {
            FRESH(a); IDS(); pg8::Gemm g{P_HB(a), P_W2T(a) + (size_t)layer * DM * FF, M, DM, FF}; pg8::StaticOrder S; S.init(M, DM, G, bx, WGM_G4);
            pg8::EpiResid E{(const float*)nullptr, (layer + 1 == DEPTH) ? a->out : (float*)nullptr, P_XB(a), SSQ_NXT(a), (LAS float*)(ldsl + LDS_X), (const float*)SSQ_MLP(a)};
            pg8::gemm_phase<pg8::EpiResid, pg8::StaticOrder, true, true>(ldsl, g, S, E);
        }
#endif
        if (layer + 1 < DEPTH) XSYNC();
    }
}

extern "C" void kernel_launch(void* const* d_in, const int* in_sizes, int n_in, void* d_out, int out_size, void* d_ws, size_t ws_size, hipStream_t stream) {
    static int grid = 0;
    if (grid == 0) {
        if (n_in != 16 || in_sizes[0] != M * DM || out_size != M * DM || ws_size < WS_END) { fprintf(stderr, "kernel_launch: unexpected shapes (n_in %d in0 %d out %d ws %zu)\n", n_in, n_in > 0 ? in_sizes[0] : -1, out_size, ws_size); grid = -1; return; }
        int dev = 0, cus = 0, per_cu = 0;
        (void)hipGetDevice(&dev); (void)hipDeviceGetAttribute(&cus, hipDeviceAttributeMultiprocessorCount, dev);
        if (hipFuncSetAttribute((const void*)fwd_megakernel, hipFuncAttributeMaxDynamicSharedMemorySize, LDS_BYTES) != hipSuccess) { fprintf(stderr, "kernel_launch: hipFuncSetAttribute failed\n"); grid = -1; return; }
        if (hipOccupancyMaxActiveBlocksPerMultiprocessor(&per_cu, (const void*)fwd_megakernel, NWAVES * 64, LDS_BYTES) != hipSuccess || per_cu < 1) { fprintf(stderr, "kernel_launch: occupancy query says %d\n", per_cu); per_cu = 1; }
        (void)hipGetLastError();
        grid = cus * 1;
        if (grid <= 0) grid = 256;
    }
    if (grid < 0) return;
    Args a{};
    a.x = (const float*)d_in[0]; a.g_mix = (const float*)d_in[1]; a.g_mlp = (const float*)d_in[2]; a.fox_w_in = (const float*)d_in[3]; a.fox_b_f = (const float*)d_in[4];
    a.fox_g_q = (const float*)d_in[5]; a.fox_g_k = (const float*)d_in[6]; a.fox_w_out = (const float*)d_in[7]; a.sgu_w_in = (const float*)d_in[8]; a.sgu_b_in = (const float*)d_in[9];
    a.sgu_g_v = (const float*)d_in[10]; a.sgu_w_s = (const float*)d_in[11]; a.sgu_b_s = (const float*)d_in[12]; a.sgu_w_out = (const float*)d_in[13]; a.mlp_w1 = (const float*)d_in[14]; a.mlp_w2 = (const float*)d_in[15];
    a.out = (float*)d_out; a.ws = (unsigned char*)d_ws;
#ifdef DBG_MEMSET
    (void)hipMemsetAsync(d_ws, 0x55, WS_END, stream); (void)hipMemsetAsync(d_out, 0x55, (size_t)M * DM * 4, stream);
#endif
    void* args[] = {&a};
    hipError_t e = hipLaunchCooperativeKernel((const void*)fwd_megakernel, dim3(grid), dim3(NWAVES * 64), args, LDS_BYTES, stream);
    if (e != hipSuccess) fprintf(stderr, "kernel_launch: cooperative launch failed: %s (grid %d)\n", hipGetErrorString(e), grid);
}
```
